# Optimizing an MI355X kernel written in HIP

```python
import jax, jax.numpy as jnp
from jax import lax
import numpy as np

D_MODEL = 1024
BATCH = 16
SEQ = 2048
DEPTH = 4

N_A_LAYERS = DEPTH // 2
N_B_LAYERS = DEPTH - N_A_LAYERS

GLA_HEADS = 4
GLA_DK = D_MODEL // 2 // GLA_HEADS
GLA_DV = D_MODEL // GLA_HEADS
GLA_QK = GLA_HEADS * GLA_DK
GLA_V = GLA_HEADS * GLA_DV
GLA_RANK = 16
GLA_TAU = 16.0
GLA_CHUNK = 64
GLA_IN = 2 * GLA_QK + 2 * GLA_V + GLA_RANK

FOX_HEAD_DIM = 64
FOX_HEADS = D_MODEL // FOX_HEAD_DIM
Q_BLOCK = 128
KV_OUT = 2 * D_MODEL + FOX_HEADS

D_FF = -(-8 * D_MODEL // (3 * 256)) * 256
EPS = 1e-6

kernel_name = "yoco_gla_fox_hybrid"


def rmsnorm(x, g):
    xf = x.astype(jnp.float32)
    y = xf * lax.rsqrt(jnp.mean(xf * xf, axis=-1, keepdims=True) + EPS) * g.astype(jnp.float32)
    return y.astype(x.dtype)


def swiglu(h, w_gu, w_down):
    gate, up = jnp.split(h @ w_gu, 2, axis=-1)
    return (jax.nn.silu(gate) * up) @ w_down


def gla_mixer(h, w_in, w_alpha_up, b_alpha, g_head, w_out):
    B, T, _ = h.shape
    NC, C = T // GLA_CHUNK, GLA_CHUNK
    proj = h @ w_in
    q, k, v, r, a_low = jnp.split(
        proj, [GLA_QK, 2 * GLA_QK, 2 * GLA_QK + GLA_V, 2 * GLA_QK + 2 * GLA_V], axis=-1)
    log_alpha = jax.nn.log_sigmoid((a_low @ w_alpha_up + b_alpha).astype(jnp.float32)) / GLA_TAU

    def heads(t, d):
        return t.astype(jnp.float32).reshape(B, NC, C, GLA_HEADS, d).transpose(0, 3, 1, 2, 4)

    q = heads(q, GLA_DK) * (GLA_DK ** -0.5)
    k = heads(k, GLA_DK)
    v = heads(v, GLA_DV)
    b = jnp.cumsum(heads(log_alpha, GLA_DK), axis=3)
    b_last = b[:, :, :, -1:, :]
    q_dec = q * jnp.exp(b)
    k_dec = k * jnp.exp(-b)
    causal = jnp.tril(jnp.ones((C, C), dtype=bool))
    A = jnp.where(causal, jnp.einsum('bhncd,bhnsd->bhncs', q_dec, k_dec), 0.0)
    o_intra = jnp.einsum('bhncs,bhnsv->bhncv', A, v)
    chunk_kv = jnp.einsum('bhncd,bhncv->bhndv', k * jnp.exp(b_last - b), v)
    chunk_decay = jnp.exp(b_last[:, :, :, 0, :])

    def step(S, inp):
        decay, kv = inp
        return decay[..., None] * S + kv, S

    S0 = jnp.zeros((B, GLA_HEADS, GLA_DK, GLA_DV), jnp.float32)
    _, S_prev = lax.scan(step, S0, (jnp.moveaxis(chunk_decay, 2, 0), jnp.moveaxis(chunk_kv, 2, 0)))
    S_prev = jnp.moveaxis(S_prev, 0, 2)
    o = o_intra + jnp.einsum('bhncd,bhndv->bhncv', q_dec, S_prev)
    o = o.transpose(0, 2, 3, 1, 4).reshape(B, T, GLA_HEADS, GLA_DV)
    o = rmsnorm(o, g_head).reshape(B, T, GLA_V)
    o = o * jax.nn.silu(r.astype(jnp.float32))
    return o.astype(h.dtype) @ w_out


def shared_kv(h, kv_norm, w_kv, b_f):
    B, T, _ = h.shape
    proj = rmsnorm(h, kv_norm) @ w_kv
    k, v, f_logit = jnp.split(proj, [D_MODEL, 2 * D_MODEL], axis=-1)
    k = k.reshape(B, T, FOX_HEADS, FOX_HEAD_DIM).transpose(0, 2, 1, 3)
    v = v.reshape(B, T, FOX_HEADS, FOX_HEAD_DIM).transpose(0, 2, 1, 3)
    log_f = jax.nn.log_sigmoid(f_logit.astype(jnp.float32) + b_f.astype(jnp.float32))
    c = jnp.cumsum(log_f, axis=1).transpose(0, 2, 1)
    return k, v, c


def fox_mixer(h, k, v, c, w_q, w_o):
    B, T, _ = h.shape
    q = (h @ w_q).reshape(B, T, FOX_HEADS, FOX_HEAD_DIM).transpose(0, 2, 1, 3)
    q = q * (FOX_HEAD_DIM ** -0.5)
    outs = []
    for blk in range(T // Q_BLOCK):
        s0, e = blk * Q_BLOCK, (blk + 1) * Q_BLOCK
        logits = jnp.einsum('bhqd,bhkd->bhqk', q[:, :, s0:e], k[:, :, :e]).astype(jnp.float32)
        logits = logits + c[:, :, s0:e, None] - c[:, :, None, :e]
        mask = (s0 + jnp.arange(Q_BLOCK))[:, None] >= jnp.arange(e)[None, :]
        p = jax.nn.softmax(jnp.where(mask, logits, -jnp.inf), axis=-1).astype(v.dtype)
        outs.append(jnp.einsum('bhqk,bhkd->bhqd', p, v[:, :, :e]))
    o = jnp.concatenate(outs, axis=2).transpose(0, 2, 1, 3).reshape(B, T, D_MODEL)
    return o @ w_o


def setup_inputs(seed: int = 0) -> dict:
    key = jax.random.key(seed)
    ks = jax.random.split(key, 20)
    f32 = jnp.float32
    D = D_MODEL
    res_scale = (2.0 * DEPTH) ** -0.5

    def nrm(k, shape, scale):
        return jax.random.normal(k, shape, f32) * scale

    def gain(k, shape):
        return 1.0 + 0.01 * jax.random.normal(k, shape, f32)

    x = jax.random.normal(ks[0], (BATCH, SEQ, D), f32)
    attn_norm = gain(ks[1], (DEPTH, D))
    ffn_norm = gain(ks[2], (DEPTH, D))
    gla_w_in = nrm(ks[3], (N_A_LAYERS, D, GLA_IN), D ** -0.5)
    gla_w_alpha_up = nrm(ks[4], (N_A_LAYERS, GLA_RANK, GLA_QK), GLA_RANK ** -0.5)
    gla_b_alpha = nrm(ks[5], (N_A_LAYERS, GLA_QK), 0.1)
    gla_g_head = gain(ks[6], (N_A_LAYERS, GLA_DV))
    gla_w_out = nrm(ks[7], (N_A_LAYERS, GLA_V, D), GLA_V ** -0.5 * res_scale)
    kv_norm = gain(ks[8], (D,))
    w_kv = jnp.concatenate([
        nrm(ks[9], (D, 2 * D), D ** -0.5),
        nrm(ks[10], (D, FOX_HEADS), 0.1 * D ** -0.5)], axis=-1)
    b_f = 3.0 + nrm(ks[11], (FOX_HEADS,), 0.1)
    fox_w_q = nrm(ks[12], (N_B_LAYERS, D, D), D ** -0.5)
    fox_w_o = nrm(ks[13], (N_B_LAYERS, D, D), D ** -0.5 * res_scale)
    ffn_w_gu = nrm(ks[14], (DEPTH, D, 2 * D_FF), D ** -0.5)
    ffn_w_down = nrm(ks[15], (DEPTH, D_FF, D), D_FF ** -0.5 * res_scale)
    final_norm = gain(ks[16], (D,))
    return {"x": x, "attn_norm": attn_norm, "ffn_norm": ffn_norm,
            "gla_w_in": gla_w_in, "gla_w_alpha_up": gla_w_alpha_up, "gla_b_alpha": gla_b_alpha,
            "gla_g_head": gla_g_head, "gla_w_out": gla_w_out,
            "kv_norm": kv_norm, "w_kv": w_kv, "b_f": b_f,
            "fox_w_q": fox_w_q, "fox_w_o": fox_w_o,
            "ffn_w_gu": ffn_w_gu, "ffn_w_down": ffn_w_down, "final_norm": final_norm}


def reference(x, attn_norm, ffn_norm, gla_w_in, gla_w_alpha_up, gla_b_alpha, gla_g_head,
              gla_w_out, kv_norm, w_kv, b_f, fox_w_q, fox_w_o, ffn_w_gu, ffn_w_down, final_norm):
    h = x
    k_sh = v_sh = c_sh = None
    for layer in range(DEPTH):
        if layer < N_A_LAYERS:
            h = h + gla_mixer(rmsnorm(h, attn_norm[layer]), gla_w_in[layer], gla_w_alpha_up[layer],
                              gla_b_alpha[layer], gla_g_head[layer], gla_w_out[layer])
        else:
            if layer == N_A_LAYERS:
                k_sh, v_sh, c_sh = shared_kv(h, kv_norm, w_kv, b_f)
            j = layer - N_A_LAYERS
            h = h + fox_mixer(rmsnorm(h, attn_norm[layer]), k_sh, v_sh, c_sh, fox_w_q[j], fox_w_o[j])
        h = h + swiglu(rmsnorm(h, ffn_norm[layer]), ffn_w_gu[layer], ffn_w_down[layer])
    return rmsnorm(h, final_norm)
```

```cpp
#include <hip/hip_runtime.h>
#include <hip/hip_bf16.h>
#include <cstdio>
#include <cstdint>
#include <cmath>

#ifndef KMODE
#define KMODE 0
#endif
#ifndef NAIVE_SCAN
#define NAIVE_SCAN 1
#endif
#ifndef NAIVE_ATTN
#define NAIVE_ATTN 1
#endif

constexpr int BATCH = 16, SEQ = 2048, DM = 1024, MTOK = BATCH * SEQ;
constexpr int GH = 4, GDK = 128, GDV = 256, GQK = 512, GV = 1024, GRANK = 16, GIN = 3088, GPROJ = 3072;
constexpr int FH = 16, FHD = 64, KVOUT = 2064;
constexpr int DFF = 2816, NGU = 2 * DFF;
constexpr float EPS = 1e-6f;
constexpr float LOG2E = 1.4426950408889634f;
constexpr float QSCALE_GLA = 0.08838834764831845f;
constexpr float QSCALE_FOX = 0.125f * LOG2E;

namespace pg8 {
#define PG8_LAS __attribute__((address_space(3)))
typedef unsigned short bf16_t;
typedef short bf16x8 __attribute__((ext_vector_type(8)));
typedef float f32x4 __attribute__((ext_vector_type(4)));
typedef unsigned u32x4 __attribute__((ext_vector_type(4)));
typedef unsigned u32x2 __attribute__((ext_vector_type(2)));
constexpr int BM = 256, BK = 64, HALF = 128, HTB = HALF * BK * 2, STAGE_BYTES = 8 * HTB, NXCD = 8, WGM = 8;

__host__ __device__ __forceinline__ int lds_byte(int r, int c) { const int st = (r >> 4) * 2 + (c >> 5), rr = r & 15, cc = c & 31, ob = rr * 64 + cc * 2; return st * 1024 + (ob ^ (((ob >> 9) & 1) << 5)); }
__host__ __device__ __forceinline__ void stage_rc(int b, int& R, int& C) { const int st = b / 1024, sb = b % 1024, swz = sb ^ (((sb >> 9) & 1) << 5); R = (st >> 1) * 16 + swz / 64; C = (st & 1) * 32 + (swz % 64) / 2; }
__host__ __device__ __forceinline__ int perm32(int rho) { const int n = rho >> 4, i = rho & 15; return 8 * (i >> 2) + 4 * n + (i & 3); }

struct Unit { int pm, pn; };
struct Gemm { const bf16_t* A; const bf16_t* Bt; int M, N, K; };

struct StaticOrder {
    int nM, nN, nwg, G, c;
    __host__ __device__ void init(int M, int N, int G_, int c_) { nM = M / BM; nN = N / BM; nwg = nM * nN; G = G_; c = c_; }
    __host__ __device__ bool next(int i, Unit& u) const {
        const long L = (long)i * G + c; if (L >= nwg) return false;
        int wgid = (int)L; { const int q = nwg / NXCD, r = nwg % NXCD, xcd = wgid % NXCD, off = wgid / NXCD; wgid = (xcd < r ? xcd * (q + 1) : r * (q + 1) + (xcd - r) * q) + off; }
        const int nig = WGM * nN, gid = wgid / nig, fm = gid * WGM, gsz = (nM - fm) < WGM ? (nM - fm) : WGM;
        u.pm = fm + ((wgid % nig) % gsz); u.pn = (wgid % nig) / gsz; return true;
    }
    __device__ __forceinline__ void a_ready(const Unit&) const {}
    __device__ __forceinline__ void done(const Unit&) const {}
};

__device__ __forceinline__ unsigned cvt_pk_bf16(float lo, float hi) { unsigned r; asm volatile("v_cvt_pk_bf16_f32 %0, %1, %2" : "=v"(r) : "v"(lo), "v"(hi)); return r; }

__device__ __forceinline__ float rstd_row(const float* part, int row) {
    const f32x4* p = (const f32x4*)(part + (size_t)row * 16);
    const f32x4 a = p[0], b = p[1], c = p[2], d = p[3];
    const float s = (((a[0] + a[1]) + (a[2] + a[3])) + ((b[0] + b[1]) + (b[2] + b[3]))) + (((c[0] + c[1]) + (c[2] + c[3])) + ((d[0] + d[1]) + (d[2] + d[3])));
    return 1.0f / sqrtf(s * (1.0f / 1024.0f) + EPS);
}
__device__ __forceinline__ float silu_f(float x) { return x * __builtin_amdgcn_rcpf(1.0f + __builtin_amdgcn_exp2f(-x * LOG2E)); }

struct EpiRowScaleBf16 {
    static constexpr bool PERM = true, AFTER_DRAIN = false;
    bf16_t* O; int ldc; const float* part; int split_cols; size_t split_stride;
    __device__ __forceinline__ void operator()(const f32x4 (&acc)[2][2][4][2], const Unit& u, int wr, int wc, int fr, int fq) const {
        const int row0 = u.pm * BM + wr * 64 + fr; int colt = u.pn * BM; bf16_t* base = O;
        if (split_cols) { const int t = colt / split_cols; base += (size_t)t * split_stride; colt -= t * split_cols; }
        const int col0 = colt + wc * 32 + 8 * fq;
#pragma unroll
        for (int ai = 0; ai < 2; ++ai)
#pragma unroll
            for (int m = 0; m < 4; ++m) { const int row = row0 + ai * HALF + m * 16; const float rs = rstd_row(part, row); bf16_t* rowp = base + (size_t)row * ldc + col0;
#pragma unroll
                for (int bj = 0; bj < 2; ++bj) { const f32x4 v0 = acc[ai][bj][m][0] * rs, v1 = acc[ai][bj][m][1] * rs;
                    u32x4 w; w.x = cvt_pk_bf16(v0[0], v0[1]); w.y = cvt_pk_bf16(v0[2], v0[3]); w.z = cvt_pk_bf16(v1[0], v1[1]); w.w = cvt_pk_bf16(v1[2], v1[3]);
                    *(u32x4*)(rowp + bj * HALF) = w; }
                asm volatile("" ::: "memory"); }
    }
};
struct EpiSwiglu {
    static constexpr bool PERM = true, AFTER_DRAIN = false;
    bf16_t* O; int ldc; const float* part;
    __device__ __forceinline__ void operator()(const f32x4 (&acc)[2][2][4][2], const Unit& u, int wr, int wc, int fr, int fq) const {
        const int row0 = u.pm * BM + wr * 64 + fr; const int col0 = u.pn * HALF + wc * 32 + 8 * fq;
#pragma unroll
        for (int ai = 0; ai < 2; ++ai)
#pragma unroll
            for (int m = 0; m < 4; ++m) { const int row = row0 + ai * HALF + m * 16; const float rs = rstd_row(part, row);
                const f32x4 g0 = acc[ai][0][m][0] * rs, g1 = acc[ai][0][m][1] * rs, u0 = acc[ai][1][m][0] * rs, u1 = acc[ai][1][m][1] * rs;
                float a[8];
#pragma unroll
                for (int i = 0; i < 4; ++i) { a[i] = silu_f(g0[i]) * u0[i]; a[4 + i] = silu_f(g1[i]) * u1[i]; }
                u32x4 w; w.x = cvt_pk_bf16(a[0], a[1]); w.y = cvt_pk_bf16(a[2], a[3]); w.z = cvt_pk_bf16(a[4], a[5]); w.w = cvt_pk_bf16(a[6], a[7]);
                *(u32x4*)(O + (size_t)row * ldc + col0) = w;
                asm volatile("" ::: "memory"); }
    }
};
struct EpiResid {
    static constexpr bool PERM = false, AFTER_DRAIN = false;
    const float* base; float* out; bf16_t* hb; float* part_out;
    __device__ __forceinline__ void operator()(const f32x4 (&acc)[2][2][4][2], const Unit& u, int wr, int wc, int fr, int fq) const {
        const int row0 = u.pm * BM + wr * 64 + fr, col0 = u.pn * BM + wc * 32 + 4 * fq;
#pragma unroll
        for (int ai = 0; ai < 2; ++ai)
#pragma unroll
            for (int m = 0; m < 4; ++m) { const int row = row0 + ai * HALF + m * 16; const size_t off = (size_t)row * DM + col0; float ss = 0.f;
#pragma unroll
                for (int bj = 0; bj < 2; ++bj)
#pragma unroll
                    for (int n = 0; n < 2; ++n) { const f32x4 bs = *(const f32x4*)(base + off + bj * HALF + n * 16); const f32x4 o = bs + acc[ai][bj][m][n];
                        *(f32x4*)(out + off + bj * HALF + n * 16) = o; ss += (o[0] * o[0] + o[1] * o[1]) + (o[2] * o[2] + o[3] * o[3]);
                        u32x2 w; w.x = cvt_pk_bf16(o[0], o[1]); w.y = cvt_pk_bf16(o[2], o[3]); *(u32x2*)(hb + off + bj * HALF + n * 16) = w; }
                ss += __shfl_xor(ss, 16); ss += __shfl_xor(ss, 32);
                if (fq == 0) part_out[(size_t)row * 16 + u.pn * 4 + wc] = ss;
                asm volatile("" ::: "memory"); }
    }
};

template <class Epi, class Sched, bool ALIGN_EPI = false, bool SP2 = false>
__device__ __forceinline__ void gemm_phase(PG8_LAS unsigned char* lds, const Gemm g, const Sched& S, const Epi& E) {
    int tid_ = threadIdx.x; asm volatile("" : "+v"(tid_));
    const int tid = tid_, wid = __builtin_amdgcn_readfirstlane(tid >> 6), lane = tid & 63, wr = wid >> 2, wc = wid & 3, fr = lane & 15, fq = lane >> 4;
    const int K = g.K, nt = K / BK;
    unsigned voffA[2], voffB[2];
#pragma unroll
    for (int i = 0; i < 2; ++i) { int R, C; stage_rc(tid * 16 + i * 8192, R, C); const int Rb = Epi::PERM ? ((R & ~31) + perm32(R & 31)) : R;
        voffA[i] = (unsigned)(R * K + C) * 2u; voffB[i] = (unsigned)(Rb * K + C) * 2u; }
    const size_t kstep = (size_t)(BK * 2);
    const size_t hstep = (size_t)HALF * K * 2;
    const size_t tstep = 2 * hstep;
    const unsigned ldsw = (unsigned)wid * 1024u;
    const int aoff = lds_byte(wr * 64 + fr, fq * 8), boff = lds_byte(wc * 32 + fr, fq * 8);
#define PG8_SA(b, h) (((b) * 2 + (h)) * HTB)
#define PG8_SB(b, h) ((4 + (b) * 2 + (h)) * HTB)
#define PG8_STAGE(bufoff, gbase, voff) do { _Pragma("unroll") for (int _i = 0; _i < 2; ++_i) \
        __builtin_amdgcn_global_load_lds((const unsigned*)((const char*)(gbase) + (voff)[_i]), (PG8_LAS unsigned*)(lds + (bufoff) + ldsw + _i * 8192), 16, 0, 0); } while (0)
#define PG8_LDA(dst, b, h) do { _Pragma("unroll") for (int m = 0; m < 4; ++m) _Pragma("unroll") for (int k = 0; k < 2; ++k) dst[m][k] = *(const PG8_LAS bf16x8*)(lds + PG8_SA(b, h) + aoff + m * 2048 + k * 1024); } while (0)
#define PG8_LDB(dst, b, h) do { _Pragma("unroll") for (int n = 0; n < 2; ++n) _Pragma("unroll") for (int k = 0; k < 2; ++k) dst[n][k] = *(const PG8_LAS bf16x8*)(lds + PG8_SB(b, h) + boff + n * 2048 + k * 1024); } while (0)
#define PG8_MMA(ai, bj, At, Bt) do { __builtin_amdgcn_s_setprio(1); _Pragma("unroll") for (int m = 0; m < 4; ++m) _Pragma("unroll") for (int n = 0; n < 2; ++n) _Pragma("unroll") for (int k = 0; k < 2; ++k) \
        acc[ai][bj][m][n] = __builtin_amdgcn_mfma_f32_16x16x32_bf16(Bt[n][k], At[m][k], acc[ai][bj][m][n], 0, 0, 0); __builtin_amdgcn_s_setprio(0); } while (0)
#define PG8_WAIT_V(n) asm volatile("s_waitcnt vmcnt(" #n ")" ::: "memory")
#define PG8_WAIT_L(n) asm volatile("s_waitcnt lgkmcnt(" #n ")" ::: "memory")
#define PG8_BAR __builtin_amdgcn_s_barrier()
#define PG8_SCHED __builtin_amdgcn_sched_barrier(0)
    Unit cur, nxt; int ui = 0;
    if (!S.next(0, cur)) return;
    f32x4 acc[2][2][4][2];
#pragma unroll
    for (int a = 0; a < 2; ++a)
#pragma unroll
        for (int b = 0; b < 2; ++b)
#pragma unroll
            for (int m = 0; m < 4; ++m)
#pragma unroll
                for (int n = 0; n < 2; ++n) acc[a][b][m][n] = (f32x4){0.f, 0.f, 0.f, 0.f};
    bf16x8 At[4][2], B0[2][2], B1[2][2];
    const char* cA = (const char*)g.A + (size_t)cur.pm * tstep; const char* cB = (const char*)g.Bt + (size_t)cur.pn * tstep;
    S.a_ready(cur);
    if constexpr (SP2) {
        PG8_STAGE(PG8_SB(0, 0), cB, voffB); PG8_STAGE(PG8_SB(0, 1), cB + hstep, voffB); PG8_STAGE(PG8_SA(0, 0), cA, voffA); PG8_STAGE(PG8_SA(0, 1), cA + hstep, voffA);
        if (wr == 1) PG8_BAR;
        PG8_WAIT_V(2); PG8_BAR;
        PG8_STAGE(PG8_SB(1, 0), cB + kstep, voffB); PG8_STAGE(PG8_SA(1, 0), cA + kstep, voffA); PG8_STAGE(PG8_SB(1, 1), cB + hstep + kstep, voffB);
        PG8_WAIT_V(6); PG8_BAR;
    } else {
        PG8_STAGE(PG8_SB(0, 0), cB, voffB); PG8_STAGE(PG8_SA(0, 0), cA, voffA); PG8_STAGE(PG8_SB(0, 1), cB + hstep, voffB); PG8_STAGE(PG8_SA(0, 1), cA + hstep, voffA);
        if (wr == 1) PG8_BAR;
        PG8_WAIT_V(4); PG8_BAR;
        PG8_STAGE(PG8_SB(1, 0), cB + kstep, voffB); PG8_STAGE(PG8_SA(1, 0), cA + kstep, voffA); PG8_STAGE(PG8_SB(1, 1), cB + hstep + kstep, voffB);
        PG8_WAIT_V(6); PG8_BAR;
    }
    for (;;) {
        const bool has_next = S.next(ui + 1, nxt);
        const char* nA = has_next ? (const char*)g.A + (size_t)nxt.pm * tstep : cA; const char* nB = has_next ? (const char*)g.Bt + (size_t)nxt.pn * tstep : cB;
        for (int t = 0; t < nt; t += 2) {
            const bool last = (t == nt - 2);
            const char* a1 = cA + (size_t)(t + 1) * kstep;
            const char* a2 = last ? nA : cA + (size_t)(t + 2) * kstep; const char* b2 = last ? nB : cB + (size_t)(t + 2) * kstep;
            const char* a3 = a2 + kstep; const char* b3 = b2 + kstep;
            if (last && has_next) S.a_ready(nxt);
            if constexpr (SP2) {
            PG8_LDB(B0, 0, 0); PG8_LDB(B1, 0, 1); PG8_SCHED; PG8_LDA(At, 0, 0); PG8_STAGE(PG8_SA(1, 1), a1 + hstep, voffA);
            PG8_WAIT_V(8); PG8_WAIT_L(0); PG8_BAR; PG8_MMA(0, 0, At, B0); PG8_MMA(0, 1, At, B1); PG8_BAR; PG8_SCHED;
            PG8_LDA(At, 0, 1); PG8_STAGE(PG8_SB(0, 0), b2, voffB); PG8_STAGE(PG8_SB(0, 1), b2 + hstep, voffB); PG8_STAGE(PG8_SA(0, 0), a2, voffA);
            PG8_WAIT_V(8); PG8_WAIT_L(0); PG8_BAR; PG8_MMA(1, 0, At, B0); PG8_MMA(1, 1, At, B1); PG8_BAR; PG8_SCHED;
            PG8_LDB(B0, 1, 0); PG8_LDB(B1, 1, 1); PG8_SCHED; PG8_LDA(At, 1, 0); PG8_STAGE(PG8_SA(0, 1), a2 + hstep, voffA);
            PG8_WAIT_V(8); PG8_WAIT_L(0); PG8_BAR; PG8_MMA(0, 0, At, B0); PG8_MMA(0, 1, At, B1); PG8_BAR; PG8_SCHED;
            PG8_LDA(At, 1, 1); PG8_STAGE(PG8_SB(1, 0), b3, voffB); PG8_STAGE(PG8_SB(1, 1), b3 + hstep, voffB); PG8_STAGE(PG8_SA(1, 0), a3, voffA);
            PG8_WAIT_V(8); PG8_WAIT_L(0); PG8_BAR; PG8_MMA(1, 0, At, B0); PG8_MMA(1, 1, At, B1); PG8_BAR; PG8_SCHED;
            } else {
            PG8_LDB(B0, 0, 0); PG8_SCHED; PG8_LDA(At, 0, 0); PG8_STAGE(PG8_SA(1, 1), a1 + hstep, voffA);
            PG8_WAIT_L(8); PG8_BAR; PG8_WAIT_L(0); PG8_MMA(0, 0, At, B0); PG8_BAR; PG8_SCHED;
            PG8_LDB(B1, 0, 1); PG8_STAGE(PG8_SB(0, 0), b2, voffB);
            PG8_BAR; PG8_WAIT_L(0); PG8_MMA(0, 1, At, B1); PG8_BAR;
            PG8_LDA(At, 0, 1); PG8_STAGE(PG8_SA(0, 0), a2, voffA);
            PG8_BAR; PG8_WAIT_L(0); PG8_MMA(1, 0, At, B0); PG8_BAR; PG8_SCHED;
            PG8_STAGE(PG8_SB(0, 1), b2 + hstep, voffB);
            PG8_WAIT_V(6); PG8_BAR; PG8_MMA(1, 1, At, B1); PG8_BAR;
            PG8_LDB(B0, 1, 0); PG8_SCHED; PG8_LDA(At, 1, 0); PG8_STAGE(PG8_SA(0, 1), a2 + hstep, voffA);
            PG8_WAIT_L(8); PG8_BAR; PG8_WAIT_L(0); PG8_MMA(0, 0, At, B0); PG8_BAR; PG8_SCHED;
            PG8_LDB(B1, 1, 1); PG8_STAGE(PG8_SB(1, 0), b3, voffB);
            PG8_BAR; PG8_WAIT_L(0); PG8_MMA(0, 1, At, B1); PG8_BAR;
            PG8_LDA(At, 1, 1); PG8_STAGE(PG8_SA(1, 0), a3, voffA);
            PG8_BAR; PG8_WAIT_L(0); PG8_MMA(1, 0, At, B0); PG8_BAR; PG8_SCHED;
            PG8_STAGE(PG8_SB(1, 1), b3 + hstep, voffB);
            PG8_WAIT_V(6); PG8_BAR; PG8_MMA(1, 1, At, B1); PG8_BAR;
            }
        }
        if constexpr (ALIGN_EPI) { if (wr == 0) PG8_BAR; }
        if constexpr (!Epi::AFTER_DRAIN) { E(acc, cur, wr, wc, fr, fq); S.done(cur); }
        if (!has_next) break;
#pragma unroll
        for (int a = 0; a < 2; ++a)
#pragma unroll
            for (int b = 0; b < 2; ++b)
#pragma unroll
                for (int m = 0; m < 4; ++m)
#pragma unroll
                    for (int n = 0; n < 2; ++n) acc[a][b][m][n] = (f32x4){0.f, 0.f, 0.f, 0.f};
        cur = nxt; cA = nA; cB = nB; ++ui;
        if constexpr (ALIGN_EPI) { if (wr == 1) PG8_BAR; }
    }
    PG8_WAIT_V(0);
    if constexpr (!ALIGN_EPI) { if (wr == 0) PG8_BAR; }
    PG8_BAR;
#undef PG8_SA
#undef PG8_SB
#undef PG8_STAGE
#undef PG8_LDA
#undef PG8_LDB
#undef PG8_MMA
#undef PG8_WAIT_V
#undef PG8_WAIT_L
#undef PG8_BAR
#undef PG8_SCHED
}
}

namespace attn_body {
using bf16=__hip_bfloat16;
using bf16x8=__attribute__((ext_vector_type(8)))short;
using s16x4=__attribute__((ext_vector_type(4)))short;
using f32x16=__attribute__((ext_vector_type(16)))float;
using f32x4=__attribute__((ext_vector_type(4)))float;
using u32x4=__attribute__((ext_vector_type(4)))unsigned;
constexpr int NHEAD=16,D=64,DMA=NHEAD*D;
constexpr int NW=8,QBLK=32,QB=QBLK*NW,KVBLK=64,NQB=SEQ/QB;
__device__ __forceinline__ int crow(int r,int hi){return (r&3)+8*(r>>2)+4*hi;}
#define SBAR() __builtin_amdgcn_sched_barrier(0)
__device__ __forceinline__ void cmask(f32x16&p0,f32x16&p1,int jb,int qrel,int hi){
  const float NEG=-INFINITY; int kb=64*jb+4*hi;
  #pragma unroll
  for(int r=0;r<16;++r){int kv=kb+(r&3)+8*(r>>2); if(kv>qrel)p0[r]=NEG; if(kv+32>qrel)p1[r]=NEG;}
}
constexpr int NSLOT=3, SLOTB=8192;
constexpr int LDS_K=0, LDS_V=NSLOT*SLOTB, LDS_WS=2*NSLOT*SLOTB, LDS_OST=LDS_WS+NW*64*4, LDS_BYTES=LDS_OST+NW*4096;
constexpr int LDS_BIAS=LDS_BYTES, LDS_BIAS_BYTES=SEQ*4, LDS_SCAN=LDS_BIAS+LDS_BIAS_BYTES, LDS_TOTAL=LDS_SCAN+64;
__device__ __forceinline__ void glds16(const void*gsrc,unsigned lds_dst){unsigned keep;
  asm volatile("s_mov_b32 %0, m0\n\ts_mov_b32 m0, %2\n\ts_nop 0\n\tglobal_load_lds_dwordx4 %1, off\n\ts_mov_b32 m0, %0":"=&s"(keep):"v"(gsrc),"s"(lds_dst):"memory");}
__device__ __forceinline__ float max3f(float a,float b,float c){float r;asm("v_max3_f32 %0, %1, %2, %3":"=v"(r):"v"(a),"v"(b),"v"(c));return r;}
__device__ __forceinline__ float max2f(float a,float b){float r;asm("v_max_f32_e32 %0, %1, %2":"=v"(r):"v"(a),"v"(b));return r;}
__device__ __forceinline__ float fadd_s(float a,float b){float r;asm("v_add_f32_e32 %0, %1, %2":"=v"(r):"v"(a),"v"(b));return r;}
__device__ __forceinline__ float fsub_s(float a,float b){float r;asm("v_sub_f32_e32 %0, %1, %2":"=v"(r):"v"(a),"v"(b));return r;}
typedef float f32x2_t __attribute__((ext_vector_type(2))); typedef __bf16 bf16x2_t __attribute__((ext_vector_type(2)));
__device__ __forceinline__ unsigned cvtpk_s(float lo,float hi){f32x2_t v={lo,hi};bf16x2_t b=__builtin_convertvector(v,bf16x2_t);return __builtin_bit_cast(unsigned,b);}
#define WAIT_BAR(N) asm volatile("s_waitcnt vmcnt(" #N ") lgkmcnt(0)\n\ts_barrier":::"memory")

__device__ __forceinline__ void qkt(f32x16&p0,f32x16&p1,const char*Kslot,const bf16x8*qr,const f32x16&negm,int r32,int hi){
  const char*kb=Kslot+hi*1024+r32*16;
  #pragma unroll
  for(int d0=0;d0<4;++d0){
    const bf16x8 b0=*reinterpret_cast<const bf16x8*>(kb+d0*2048);
    const bf16x8 b1=*reinterpret_cast<const bf16x8*>(kb+d0*2048+512);
    if(d0==0){p0=__builtin_amdgcn_mfma_f32_32x32x16_bf16(b0,qr[0],negm,0,0,0);p1=__builtin_amdgcn_mfma_f32_32x32x16_bf16(b1,qr[0],negm,0,0,0);}
    else{p0=__builtin_amdgcn_mfma_f32_32x32x16_bf16(b0,qr[d0],p0,0,0,0);p1=__builtin_amdgcn_mfma_f32_32x32x16_bf16(b1,qr[d0],p1,0,0,0);}}
}
typedef __attribute__((address_space(3))) const char* lds_cptr;
typedef short v4i16_t __attribute__((ext_vector_type(4)));
__device__ __forceinline__ void kload8(bf16x8*kf,lds_cptr kp){
  kf[0]=*(const __attribute__((address_space(3))) bf16x8*)(kp);      kf[1]=*(const __attribute__((address_space(3))) bf16x8*)(kp+512);
  kf[2]=*(const __attribute__((address_space(3))) bf16x8*)(kp+2048); kf[3]=*(const __attribute__((address_space(3))) bf16x8*)(kp+2560);
  kf[4]=*(const __attribute__((address_space(3))) bf16x8*)(kp+4096); kf[5]=*(const __attribute__((address_space(3))) bf16x8*)(kp+4608);
  kf[6]=*(const __attribute__((address_space(3))) bf16x8*)(kp+6144); kf[7]=*(const __attribute__((address_space(3))) bf16x8*)(kp+6656);
}
__device__ __forceinline__ void kload2(bf16x8*kf,lds_cptr kp,int j){ kf[2*j]=*(const __attribute__((address_space(3))) bf16x8*)(kp+j*2048); kf[2*j+1]=*(const __attribute__((address_space(3))) bf16x8*)(kp+j*2048+512); }
__device__ __forceinline__ s16x4 vtr(lds_cptr p){ return __builtin_bit_cast(s16x4,__builtin_amdgcn_ds_read_tr16_b64_v4i16((__attribute__((address_space(3))) v4i16_t*)p)); }
__device__ __forceinline__ float rowmax(const f32x16&p0,const f32x16&p1){
  float a=max3f(p0[0],p0[1],p1[0]),b=max3f(p0[2],p0[3],p1[1]);a=max3f(a,p1[2],p1[3]);
  #pragma unroll
  for(int r=4;r<16;r+=4){a=max3f(a,p0[r],p0[r+1]);b=max3f(b,p0[r+2],p0[r+3]);a=max3f(a,p1[r],p1[r+1]);b=max3f(b,p1[r+2],p1[r+3]);}
  const float m=max2f(a,b);
  auto rr=__builtin_amdgcn_permlane32_swap(__float_as_uint(m),__float_as_uint(m),false,false);
  return max2f(__uint_as_float(rr[0]),__uint_as_float(rr[1]));
}
__device__ __forceinline__ void pv(f32x16*o,int vb,bf16x8 pa0,bf16x8 pa1,bf16x8 pa2,bf16x8 pa3){
  #pragma unroll
  for(int d0=0;d0<2;++d0){s16x4 lo[4],hi[4];
    #pragma unroll
    for(int ks=0;ks<4;++ks){
      asm volatile("ds_read_b64_tr_b16 %0,%1 offset:%c2":"=&v"(lo[ks]):"v"(vb),"i"(d0*4096+ks*1024):"memory");
      asm volatile("ds_read_b64_tr_b16 %0,%1 offset:%c2":"=&v"(hi[ks]):"v"(vb),"i"(d0*4096+ks*1024+512):"memory");}
    asm volatile("s_waitcnt lgkmcnt(0)":::"memory");SBAR();
    #define PK(k) (bf16x8){lo[k][0],lo[k][1],lo[k][2],lo[k][3],hi[k][0],hi[k][1],hi[k][2],hi[k][3]}
    o[d0]=__builtin_amdgcn_mfma_f32_32x32x16_bf16(pa0,PK(0),o[d0],0,0,0);
    o[d0]=__builtin_amdgcn_mfma_f32_32x32x16_bf16(pa1,PK(1),o[d0],0,0,0);
    o[d0]=__builtin_amdgcn_mfma_f32_32x32x16_bf16(pa2,PK(2),o[d0],0,0,0);
    o[d0]=__builtin_amdgcn_mfma_f32_32x32x16_bf16(pa3,PK(3),o[d0],0,0,0);
    #undef PK
  }
}
__device__ __forceinline__ void kbias(f32x16&p0,f32x16&p1,const __attribute__((address_space(3))) float*bt,int t,int hi){
  const __attribute__((address_space(3))) f32x4*b4=(const __attribute__((address_space(3))) f32x4*)(bt+64*t+4*hi);
  #pragma unroll
  for(int g=0;g<4;++g){ const f32x4 x=b4[2*g], y=b4[2*g+8];
    #pragma unroll
    for(int i=0;i<4;++i){p0[4*g+i]+=x[i];p1[4*g+i]+=y[i];} }
}

#ifndef ATTN_STORE16
#define ATTN_STORE16(p,v) (*(u32x4*)(p)=(v))
#endif
template<int THRL> __device__ __forceinline__ void attn_unit(int b,int h,int qb,const bf16*Q,const bf16*__restrict__ K,const bf16*__restrict__ V,bf16*O,char*shm){
  const int tid=threadIdx.x,lane=tid&63,r32=lane&31,hi=lane>>5; const int wid=__builtin_amdgcn_readfirstlane(tid>>6);
  const long rowbase=(long)b*SEQ; const int q0=qb*QB;
  const bf16*Qw=Q+(rowbase+q0+wid*QBLK)*DMA+h*D;
  const bf16*Kh=K+rowbase*DMA+h*D,*Vh=V+rowbase*DMA+h*D;
  const unsigned lds0=(unsigned)(uintptr_t)shm;
  float*wsf=(float*)(shm+LDS_WS)+wid*64;
  const __attribute__((address_space(3))) float*bt=(const __attribute__((address_space(3))) float*)((lds_cptr)shm+LDS_BIAS);
  const bf16*ksrc=Kh+(long)lane*DMA+wid*8;
  const bf16*vsrc=Vh+(long)(16*(wid&3)+(lane>>2))*DMA+(wid>>2)*32+(lane&3)*8;
  const unsigned kdst=lds0+LDS_K+wid*1024, vdst=lds0+LDS_V+wid*1024;
  #define DMA_K(t,slot) glds16(ksrc+(long)(t)*KVBLK*DMA,(unsigned)__builtin_amdgcn_readfirstlane(kdst+(slot)))
  #define DMA_V(t,slot) glds16(vsrc+(long)(t)*KVBLK*DMA,(unsigned)__builtin_amdgcn_readfirstlane(vdst+(slot)))
  const int vb0=(int)(lds0+LDS_V)+((lane>>4)&1)*32+(lane&3)*8+(4*hi+((lane&15)>>2))*64;
  const char*Kbase=shm+LDS_K; bf16x8 kf[8];
  const lds_cptr shm3=(lds_cptr)shm; const lds_cptr kp0=shm3+LDS_K+hi*1024+r32*16; const lds_cptr vp0=shm3+LDS_V+((lane>>4)&1)*32+(lane&3)*8+(4*hi+((lane&15)>>2))*64;
  const int NT=(q0+QB)/KVBLK;
  DMA_K(0,0);DMA_V(0,0);DMA_K(1,SLOTB);
  bf16x8 qr[4];
  #pragma unroll
  for(int d0=0;d0<4;++d0)qr[d0]=*reinterpret_cast<const bf16x8*>(&Qw[(long)r32*DMA+d0*16+hi*8]);
  const int qrel=wid*QBLK+r32;
  float mhat=bt[q0+qrel],l_reg=0.f;f32x16 o[2];o[0]=f32x16{};o[1]=f32x16{};f32x16 negm;
  #pragma unroll
  for(int r=0;r<16;++r)negm[r]=-mhat;
  asm volatile("":"+v"(negm));
  #define CMASK(P0,P1,t) do{int jb_=(t)-(NT-4); if(jb_>=0)cmask(P0,P1,jb_,qrel,hi);}while(0)
  bool resc=false;
  #define START(P0,P1) do{ const float rm=rowmax(P0,P1); resc=false; \
    { const float dl=rm; mhat=fadd_s(mhat,dl); \
      _Pragma("unroll") for(int r=0;r<16;++r){P0[r]=fsub_s(P0[r],dl);P1[r]=fsub_s(P1[r],dl);} \
      _Pragma("unroll") for(int r=0;r<16;++r)negm[r]=-mhat; asm volatile("":"+v"(negm)); } \
    _Pragma("unroll") for(int r=0;r<16;++r)P0[r]=__builtin_amdgcn_exp2f(P0[r]); }while(0)
  #define RESC() do{ if(resc){ asm volatile("s_waitcnt lgkmcnt(0)":::"memory"); \
      _Pragma("unroll") for(int d_=0;d_<2;++d_) _Pragma("unroll") for(int r=0;r<16;++r)o[d_][r]*=wsf[crow(r,hi)]; } }while(0)
  f32x16 pA0,pA1,pB0,pB1;
  int sl_prev=0,sl_cur=0,sl_next=SLOTB;
  #define ROT() do{sl_prev=sl_cur;sl_cur=sl_next;sl_next=(sl_next==(NSLOT-1)*SLOTB)?0:sl_next+SLOTB;}while(0)
  DMA_K(2,2*SLOTB);
  WAIT_BAR(3);
  qkt(pA0,pA1,Kbase,qr,negm,r32,hi);asm volatile("s_nop 15\n\ts_nop 7":"+v"(pA0),"+v"(pA1));kbias(pA0,pA1,bt,0,hi);CMASK(pA0,pA1,0);
  START(pA0,pA1);
  _Pragma("unroll") for(int r=0;r<16;++r)pA1[r]=__builtin_amdgcn_exp2f(pA1[r]);
  WAIT_BAR(0);
  DMA_K(3,0);DMA_V(1,SLOTB);
  ROT();
  kload8(kf,kp0+sl_cur);
  WAIT_BAR(2);
  s16x4 vlo[8],vhi[8]; u32x4 pw0,pw1,pw2,pw3;
  #define PKW(P,B) cvtpk_s(P[B],P[B+1])
  #define PAF(k) __builtin_bit_cast(bf16x8,pw##k)
  #define VFR(i) (bf16x8){vlo[i][0],vlo[i][1],vlo[i][2],vlo[i][3],vhi[i][0],vhi[i][1],vhi[i][2],vhi[i][3]}
  #define PIN(x) asm volatile("":"+v"(x))
  #define MX3(a,b,c) __builtin_fmaxf(__builtin_fmaxf((a),(b)),(c))
  #define GAPA(MF,A0,A1,A2,A3,W0,W1,PW) do{ MF; sacc+=A0; sacc+=A1; sacc+=A2; sacc+=A3; PIN(sacc); W0; W1; PIN(PW); SBAR(); }while(0)
  #define EX(v) __builtin_amdgcn_exp2f(v)
  #define GAPB(MF,X,B) do{ MF; X[B]=EX(X[B]); X[B+1]=EX(X[B+1]); X[B+2]=EX(X[B+2]); X[B+3]=EX(X[B+3]); PIN(X); SBAR(); }while(0)
  #define VRD(i) do{ vlo[i]=vtr(vp_+(((i)>>2)*4096+((i)&3)*1024)); vhi[i]=vtr(vp_+(((i)>>2)*4096+((i)&3)*1024+512)); }while(0)
  #define KRD(G,j) do{ if(G){ kload2(kf,kp0+sl_next,j); SBAR(); } }while(0)
  #define STEP(C0,C1,P0,P1,t,GK,GV,GL) do{ SBAR(); \
    const lds_cptr vp_=vp0+sl_prev; \
    VRD(0); SBAR(); float sacc=(P0[0]+P0[1]); \
    GAPA(C0=__builtin_amdgcn_mfma_f32_32x32x16_bf16(kf[0],qr[0],negm,0,0,0), P0[2],P0[3],P0[4],P0[5],     pw0[0]=PKW(P0,0), pw0[1]=PKW(P0,2), pw0); \
    VRD(4); SBAR(); GAPA(C1=__builtin_amdgcn_mfma_f32_32x32x16_bf16(kf[1],qr[0],negm,0,0,0), P0[6],P0[7],P0[8],P0[9],     pw0[2]=PKW(P0,4), pw0[3]=PKW(P0,6), pw0); \
    VRD(1); SBAR(); GAPA(C0=__builtin_amdgcn_mfma_f32_32x32x16_bf16(kf[2],qr[1],C0,0,0,0),   P0[10],P0[11],P0[12],P0[13], pw1[0]=PKW(P0,8), pw1[1]=PKW(P0,10), pw1); \
    VRD(5); SBAR(); GAPA(C1=__builtin_amdgcn_mfma_f32_32x32x16_bf16(kf[3],qr[1],C1,0,0,0),   P0[14],P0[15],P1[0],P1[1],   pw1[2]=PKW(P0,12),pw1[3]=PKW(P0,14), pw1); \
    VRD(2); SBAR(); GAPA(C0=__builtin_amdgcn_mfma_f32_32x32x16_bf16(kf[4],qr[2],C0,0,0,0),   P1[2],P1[3],P1[4],P1[5],     pw2[0]=PKW(P1,0), pw2[1]=PKW(P1,2), pw2); \
    VRD(6); SBAR(); GAPA(C1=__builtin_amdgcn_mfma_f32_32x32x16_bf16(kf[5],qr[2],C1,0,0,0),   P1[6],P1[7],P1[8],P1[9],     pw2[2]=PKW(P1,4), pw2[3]=PKW(P1,6), pw2); \
    VRD(3); SBAR(); GAPA(C0=__builtin_amdgcn_mfma_f32_32x32x16_bf16(kf[6],qr[3],C0,0,0,0),   P1[10],P1[11],P1[12],P1[13], pw3[0]=PKW(P1,8), pw3[1]=PKW(P1,10), pw3); \
    VRD(7); SBAR(); GAPA(C1=__builtin_amdgcn_mfma_f32_32x32x16_bf16(kf[7],qr[3],C1,0,0,0),   P1[14],P1[15],0.f,0.f,       pw3[2]=PKW(P1,12),pw3[3]=PKW(P1,14), pw3); \
    l_reg+=sacc; \
    if(GK){DMA_K((t)+3,sl_cur);} if(GV){DMA_V((t)+1,sl_next);} \
    kbias(C0,C1,bt,t,hi); \
    CMASK(C0,C1,t); \
    { float a=MX3(C0[0],C0[1],C1[0]),b=MX3(C0[2],C0[3],C1[1]); a=MX3(a,C1[2],C1[3]); \
      _Pragma("unroll") for(int r=4;r<16;r+=4){a=MX3(a,C0[r],C0[r+1]);b=MX3(b,C0[r+2],C0[r+3]);a=MX3(a,C1[r],C1[r+1]);b=MX3(b,C1[r+2],C1[r+3]);} \
      float rm=__builtin_fmaxf(a,b); { auto rr=__builtin_amdgcn_permlane32_swap(__float_as_uint(rm),__float_as_uint(rm),false,false); rm=__builtin_fmaxf(__uint_as_float(rr[0]),__uint_as_float(rr[1])); } \
      resc=false; \
      if(__builtin_expect(__any(rm>(float)THRL),0)){ const float dl=__builtin_fmaxf(rm,0.f); mhat+=dl; \
        _Pragma("unroll") for(int r=0;r<16;++r){C0[r]-=dl;C1[r]-=dl;} \
        _Pragma("unroll") for(int r=0;r<16;++r)negm[r]=-mhat; asm volatile("":"+v"(negm)); \
        const float f=__builtin_amdgcn_exp2f(-dl); l_reg*=f; if(hi==0)wsf[r32]=f; resc=true; } } \
    SBAR(); \
    GAPB(o[0]=__builtin_amdgcn_mfma_f32_32x32x16_bf16(PAF(0),VFR(0),o[0],0,0,0), C0,0); \
    GAPB(o[1]=__builtin_amdgcn_mfma_f32_32x32x16_bf16(PAF(0),VFR(4),o[1],0,0,0), C0,4); \
    KRD(GL,0); GAPB(o[0]=__builtin_amdgcn_mfma_f32_32x32x16_bf16(PAF(1),VFR(1),o[0],0,0,0), C0,8); \
    KRD(GL,1); GAPB(o[1]=__builtin_amdgcn_mfma_f32_32x32x16_bf16(PAF(1),VFR(5),o[1],0,0,0), C0,12); \
    KRD(GL,2); GAPB(o[0]=__builtin_amdgcn_mfma_f32_32x32x16_bf16(PAF(2),VFR(2),o[0],0,0,0), C1,0); \
    KRD(GL,3); GAPB(o[1]=__builtin_amdgcn_mfma_f32_32x32x16_bf16(PAF(2),VFR(6),o[1],0,0,0), C1,4); \
    GAPB(o[0]=__builtin_amdgcn_mfma_f32_32x32x16_bf16(PAF(3),VFR(3),o[0],0,0,0), C1,8); \
    GAPB(o[1]=__builtin_amdgcn_mfma_f32_32x32x16_bf16(PAF(3),VFR(7),o[1],0,0,0), C1,12); \
    }while(0)
  int t=1;
  #undef CMASK
  #define CMASK(P0,P1,t) do{}while(0)
  for(;t+5<NT;t+=2){
    STEP(pB0,pB1,pA0,pA1,t,true,true,true);     WAIT_BAR(2); RESC(); ROT();
    STEP(pA0,pA1,pB0,pB1,t+1,true,true,true);   WAIT_BAR(2); RESC(); ROT();
  }
  #undef CMASK
  #define CMASK(P0,P1,t) do{int jb_=(t)-(NT-4); if(jb_>=0)cmask(P0,P1,jb_,qrel,hi);}while(0)
  #define ENDW(tt) do{ if((tt)+3<NT){WAIT_BAR(2);} else if((tt)+2<NT){WAIT_BAR(1);} else {WAIT_BAR(0);} }while(0)
  for(;t+1<NT;t+=2){
    STEP(pB0,pB1,pA0,pA1,t,(t+3<NT),(t+1<NT),(t+1<NT));       ENDW(t);   RESC(); ROT();
    STEP(pA0,pA1,pB0,pB1,t+1,(t+4<NT),(t+2<NT),(t+2<NT));     ENDW(t+1); RESC(); ROT();
  }
  STEP(pB0,pB1,pA0,pA1,NT-1,false,false,false); RESC();
  { float sacc=pB0[0]+pB0[1]; _Pragma("unroll") for(int r=2;r<16;++r)sacc+=pB0[r]; _Pragma("unroll") for(int r=0;r<16;++r)sacc+=pB1[r]; l_reg+=sacc;
    pw0=(u32x4){PKW(pB0,0),PKW(pB0,2),PKW(pB0,4),PKW(pB0,6)};pw1=(u32x4){PKW(pB0,8),PKW(pB0,10),PKW(pB0,12),PKW(pB0,14)};pw2=(u32x4){PKW(pB1,0),PKW(pB1,2),PKW(pB1,4),PKW(pB1,6)};pw3=(u32x4){PKW(pB1,8),PKW(pB1,10),PKW(pB1,12),PKW(pB1,14)};
    SBAR(); pv(o,vb0+sl_cur,PAF(0),PAF(1),PAF(2),PAF(3)); }
  #undef PKW
  #undef PAF
  #undef VFR
  #undef PIN
  #undef MX3
  #undef GAPA
  #undef GAPB
  #undef EX
  #undef VRD
  #undef KRD
  #undef STEP
  #undef ENDW
  {auto rr=__builtin_amdgcn_permlane32_swap(__float_as_uint(l_reg),__float_as_uint(l_reg),false,false);l_reg=__uint_as_float(rr[0])+__uint_as_float(rr[1]);}
  if(hi==0)wsf[32+r32]=l_reg;asm volatile("s_waitcnt lgkmcnt(0)":::"memory");
  float rli[16];
  #pragma unroll
  for(int r=0;r<16;++r)rli[r]=__builtin_amdgcn_rcpf(wsf[32+crow(r,hi)]);
  bf16*Ow=O+(rowbase+q0+wid*QBLK)*DMA+h*D;
  { bf16*stg=(bf16*)(shm+LDS_OST)+wid*2048;
    #pragma unroll
    for(int r=0;r<16;++r){const int orow=crow(r,hi);
      #pragma unroll
      for(int d0=0;d0<2;++d0)stg[orow*64+d0*32+r32]=__float2bfloat16(o[d0][r]*rli[r]);}
    asm volatile("s_waitcnt lgkmcnt(0)":::"memory");
    #pragma unroll
    for(int i=0;i<4;++i){const int row=i*8+(lane>>3),ch=lane&7; const u32x4 v=*(const u32x4*)(stg+row*64+ch*8); ATTN_STORE16(Ow+(long)row*DMA+ch*8,v);} }
  asm volatile("s_waitcnt lgkmcnt(0)\n\ts_barrier":::"memory");
  #undef DMA_K
  #undef DMA_V
  #undef CMASK
  #undef START
  #undef RESC
  #undef ROT
}
#undef SBAR
#undef WAIT_BAR
}

constexpr size_t MiB = 1u << 20;
constexpr size_t WS_CTL = 0, CTL_ZERO_BYTES = 1 * MiB;
constexpr size_t WS_PART = 1 * MiB;
constexpr size_t WS_SKIN = 3 * MiB;
constexpr size_t WS_WSK  = 5 * MiB;
constexpr size_t WS_CUM  = 6 * MiB;
constexpr size_t WS_WIN = 8 * MiB, WS_WOUT = 20 * MiB, WS_WGU = 24 * MiB, WS_WDOWN = 68 * MiB, WS_WKVQ = 90 * MiB, WS_WQ3 = 96 * MiB, WS_WO = 98 * MiB;
constexpr size_t WS_HB = 104 * MiB;
constexpr size_t WS_BIG = 168 * MiB;
constexpr size_t WS_PROJ = WS_BIG;
constexpr size_t WS_OA = WS_BIG + 192 * MiB;
constexpr size_t WS_ACT_GLA = WS_BIG;
constexpr size_t WS_K = WS_BIG, WS_V = WS_BIG + 64 * MiB, WS_QO = WS_BIG + 128 * MiB;
constexpr size_t WS_ACT_FOX = WS_BIG + 128 * MiB;
constexpr size_t WS_END = WS_BIG + 128 * MiB + 176 * MiB;
static_assert(WS_END <= 512 * MiB, "workspace map");
constexpr int CW_BAR = 4096;

constexpr int NWAVES = 8;
constexpr int RING_OFF = 0, RING_BYTES = 131072;
constexpr int LDSCTL_OFF = RING_BYTES, MISC_OFF = LDSCTL_OFF + 320;
constexpr int LDS_BYTES = 147456;

#define GAS __attribute__((address_space(1)))
#define LAS __attribute__((address_space(3)))
typedef unsigned short bf16;
typedef unsigned v4u __attribute__((ext_vector_type(4)));
typedef unsigned v2u __attribute__((ext_vector_type(2)));
typedef float f32x4 __attribute__((ext_vector_type(4)));
typedef short bf16x8 __attribute__((ext_vector_type(8)));
typedef GAS unsigned gu32;
#define RLX_AGENT __ATOMIC_RELAXED, __HIP_MEMORY_SCOPE_AGENT
#define LDS_WAIT() asm volatile("s_waitcnt lgkmcnt(0)" ::: "memory")
#define VM_WAIT() asm volatile("s_waitcnt vmcnt(0)" ::: "memory")
__device__ __forceinline__ unsigned f2bf(float f) { unsigned u = __builtin_bit_cast(unsigned, f); return (u + 0x7fffu + ((u >> 16) & 1u)) >> 16; }
__device__ __forceinline__ unsigned pk2(float lo, float hi) { return f2bf(lo) | (f2bf(hi) << 16); }
__device__ __forceinline__ float bf2f(unsigned short b) { return __builtin_bit_cast(float, (unsigned)b << 16); }
__device__ __forceinline__ float log_sigmoid_f(float x) { return fminf(x, 0.f) - log1pf(expf(-fabsf(x))); }

#define XB_TMO      128
#define XB_XCNT(j)  (256  + 64 * (j))
#define XB_XSUB(j)  (1280 + 64 * (j))
#define XB_XGEN(j)  (2304 + 64 * (j))
#define XB_TOP      3328
#define XB_TOPGEN   3392
#define XCD_BAR_WORDS 3456
#define XB_SPIN_CAP (1u << 18)
__device__ __forceinline__ unsigned xb_ld(unsigned* p)              { return __hip_atomic_load(p, __ATOMIC_RELAXED, __HIP_MEMORY_SCOPE_AGENT); }
__device__ __forceinline__ unsigned xb_add(unsigned* p, unsigned v) { return __hip_atomic_fetch_add(p, v, __ATOMIC_RELAXED, __HIP_MEMORY_SCOPE_AGENT); }
__device__ __forceinline__ unsigned xb_xcc_id() { return (unsigned)__builtin_amdgcn_s_getreg((3 << 11) | 20) & 0xFu; }
#define XB_SPIN(cond, bar) do { unsigned _sp = 0; while (cond) { __builtin_amdgcn_s_sleep(1); \
    if ((++_sp & 255u) == 0u) { if (xb_ld(&(bar)[XB_TMO])) break; if (_sp > XB_SPIN_CAP) { atomicAdd(&(bar)[XB_TMO], 1u); break; } } } } while (0)
struct XcdBarrier { unsigned* bar; unsigned x; volatile LAS unsigned* st; };
__device__ __forceinline__ XcdBarrier xcd_barrier_post(unsigned* bar, volatile LAS unsigned* st) {
    XcdBarrier b; b.bar = bar; b.x = xb_xcc_id(); b.st = st;
    if (threadIdx.x == 0) (void)xb_add(&bar[XB_XCNT(b.x)], 1u);
    return b;
}
__device__ __forceinline__ void xcd_barrier_complete(unsigned* bar, unsigned x, unsigned& nloc, unsigned& nx) {
    const unsigned G = gridDim.x * gridDim.y * gridDim.z;
    unsigned sum, cnt, mine, sp = 0u;
    for (;;) {
        sum = 0u; cnt = 0u; mine = 0u;
#pragma unroll
        for (unsigned j = 0; j < 16; ++j) { const unsigned c = xb_ld(&bar[XB_XCNT(j)]); sum += c; cnt += (c > 0u) ? 1u : 0u; mine = (j == x) ? c : mine; }
        if (sum == G) break;
        __builtin_amdgcn_s_sleep(1);
        if ((++sp & 255u) == 0u) { if (xb_ld(&bar[XB_TMO])) break; if (sp > XB_SPIN_CAP) { atomicAdd(&bar[XB_TMO], 1u); break; } }
    }
    nloc = mine > 0u ? mine : 1u; nx = cnt > 0u ? cnt : 1u;
}
__device__ __forceinline__ void xcd_barrier(const XcdBarrier& b) {
    asm volatile("s_waitcnt vmcnt(0)" ::: "memory");
    __syncthreads();
    if (threadIdx.x == 0) {
        unsigned* bar = b.bar;
        __builtin_amdgcn_s_waitcnt(0);
        unsigned nloc = b.st[0], nx = b.st[1];
        if (nloc == 0u) { xcd_barrier_complete(bar, b.x, nloc, nx); b.st[0] = nloc; b.st[1] = nx; }
        const unsigned old = xb_add(&bar[XB_XSUB(b.x)], 1u);
        const unsigned gen = old / nloc;
        if (old + 1u == (gen + 1u) * nloc) {
            __builtin_amdgcn_fence(__ATOMIC_RELEASE, "agent");
            asm volatile("s_waitcnt vmcnt(0)" ::: "memory");
            const unsigned og = xb_add(&bar[XB_TOP], 1u);
            const unsigned tg = og / nx;
            if (og + 1u == (tg + 1u) * nx) xb_add(&bar[XB_TOPGEN], 1u);
            else XB_SPIN(xb_ld(&bar[XB_TOPGEN]) == tg, bar);
            __builtin_amdgcn_fence(__ATOMIC_ACQUIRE, "agent");
            xb_add(&bar[XB_XGEN(b.x)], 1u);
            asm volatile("s_waitcnt vmcnt(0)" ::: "memory");
        } else {
            XB_SPIN(xb_ld(&bar[XB_XGEN(b.x)]) == gen, bar);
            __builtin_amdgcn_fence(__ATOMIC_ACQUIRE, "agent");
            asm volatile("s_waitcnt vmcnt(0)" ::: "memory");
        }
    }
    __syncthreads();
}

struct Frame {
    LAS unsigned char* lds;
    volatile LAS unsigned* MISC;
    gu32* ctl;
    int tid, lane, wave;
    int vcu, G;
};
__device__ __forceinline__ float wave_sum(float v) {
#pragma unroll
    for (int o = 1; o < 64; o <<= 1) v += __shfl_xor(v, o);
    return v;
}

__device__ __forceinline__ void p0_transpose_item(const float* W, int ldw, int c0, int ncols, int K, const float* gain, float scale, int scale_cols, bf16* WT, int mode, LAS float* scr, int item, int lane) {
    const int nblk = ncols / 32, kb = item / nblk, nb = item % nblk, k0 = 64 * kb, n0 = 32 * nb;
#pragma unroll 8
    for (int i = 0; i < 32; ++i) { const int kk = 2 * i + (lane >> 5); const float gk = gain ? gain[k0 + kk] : 1.0f; scr[kk * 33 + (lane & 31)] = W[(size_t)(k0 + kk) * ldw + c0 + n0 + (lane & 31)] * gk; }
    LDS_WAIT(); asm volatile("" ::: "memory");
    const float sc = (n0 < scale_cols) ? scale : 1.0f;
    const int c = lane & 7;
#pragma unroll
    for (int j = 0; j < 4; ++j) { const int n = (lane >> 3) + 8 * j; const LAS float* s = scr + (8 * c) * 33 + n;
        v4u o; o.x = pk2(s[0 * 33] * sc, s[1 * 33] * sc); o.y = pk2(s[2 * 33] * sc, s[3 * 33] * sc); o.z = pk2(s[4 * 33] * sc, s[5 * 33] * sc); o.w = pk2(s[6 * 33] * sc, s[7 * 33] * sc);
        const int nn = n0 + n; int row = nn;
        if (mode == 1) { row = (nn < DFF) ? (256 * (nn / 128) + (nn % 128)) : (256 * ((nn - DFF) / 128) + 128 + ((nn - DFF) % 128)); }
        *(GAS v4u*)(WT + (size_t)row * K + k0 + 8 * c) = o; }
    LDS_WAIT(); asm volatile("" ::: "memory");
}

struct Args { const float* in[16]; float* out; unsigned char* ws; int lo, hi; };

__device__ __forceinline__ void skinny_phase(const Frame& F, const bf16* hb, const bf16* Wt, const float* part, float* out) {
    const int gw = F.vcu * NWAVES + F.wave, NGW = F.G * NWAVES, fr = F.lane & 15, fq = F.lane >> 4;
    for (int tile = gw; tile < MTOK / 16; tile += NGW) {
        const int row0 = tile * 16;
        const bf16* ap = hb + (size_t)(row0 + fr) * DM + fq * 8; const bf16* bp = Wt + (size_t)fr * DM + fq * 8;
        f32x4 acc = (f32x4){0.f, 0.f, 0.f, 0.f};
#pragma unroll 8
        for (int ks = 0; ks < DM / 32; ++ks) { const bf16x8 a = *(const bf16x8*)(ap + 32 * ks), b = *(const bf16x8*)(bp + 32 * ks); acc = __builtin_amdgcn_mfma_f32_16x16x32_bf16(a, b, acc, 0, 0, 0); }
#pragma unroll
        for (int r = 0; r < 4; ++r) { const int row = row0 + 4 * fq + r; out[(size_t)row * 16 + fr] = acc[r] * pg8::rstd_row(part, row); }
    }
}

__device__ __forceinline__ void gate_phase(const Frame& F, bf16* oa, const bf16* proj, const float* ghead) {
    const int gw = F.vcu * NWAVES + F.wave, NGW = F.G * NWAVES;
    for (int m = gw; m < MTOK; m += NGW) {
#pragma unroll
        for (int j = 0; j < 2; ++j) {
            const int col = F.lane * 8 + 512 * j;
            const v4u ov = *(const GAS v4u*)(oa + (size_t)m * GV + col); const v4u rv = *(const GAS v4u*)(proj + (size_t)m * GPROJ + 2048 + col);
            float o[8], r[8];
#pragma unroll
            for (int i = 0; i < 4; ++i) { o[2 * i] = __builtin_bit_cast(float, ov[i] << 16); o[2 * i + 1] = __builtin_bit_cast(float, ov[i] & 0xffff0000u); r[2 * i] = __builtin_bit_cast(float, rv[i] << 16); r[2 * i + 1] = __builtin_bit_cast(float, rv[i] & 0xffff0000u); }
            float ss = 0.f;
#pragma unroll
            for (int i = 0; i < 8; ++i) ss += o[i] * o[i];
#pragma unroll
            for (int s = 1; s < 32; s <<= 1) ss += __shfl_xor(ss, s);
            const float rs = 1.0f / sqrtf(ss * (1.0f / 256.0f) + EPS);
            const f32x4 g0 = *(const GAS f32x4*)(ghead + (col & 255)), g1 = *(const GAS f32x4*)(ghead + (col & 255) + 4);
            float a[8];
#pragma unroll
            for (int i = 0; i < 8; ++i) { const float g = i < 4 ? g0[i] : g1[i - 4]; a[i] = o[i] * rs * g * pg8::silu_f(r[i]); }
            v4u w; w.x = pk2(a[0], a[1]); w.y = pk2(a[2], a[3]); w.z = pk2(a[4], a[5]); w.w = pk2(a[6], a[7]);
            *(GAS v4u*)(oa + (size_t)m * GV + col) = w;
        }
    }
}

__device__ __forceinline__ void final_phase(const Frame& F, float* out, const float* part, const float* g) {
    const int gw = F.vcu * NWAVES + F.wave, NGW = F.G * NWAVES;
    for (int m = gw; m < MTOK; m += NGW) {
        const float rs = pg8::rstd_row(part, m);
        GAS f32x4* xr = (GAS f32x4*)(out + (size_t)m * DM) + F.lane;
#pragma unroll
        for (int j = 0; j < 4; ++j) { const f32x4 v = xr[64 * j]; const f32x4 gg = *((const GAS f32x4*)g + F.lane + 64 * j); xr[64 * j] = v * rs * gg; }
    }
}

__device__ __forceinline__ void attn_phase(const Frame& F, unsigned char* lds_generic, const float* flog, const float* b_f, const bf16* Q, const bf16* K, const bf16* V, bf16* O) {
    for (int bh = F.vcu; bh < BATCH * FH; bh += F.G) {
        const int b = bh / FH, h = bh % FH;
        LAS float* bt = (LAS float*)(F.lds + RING_OFF + attn_body::LDS_BIAS); LAS float* wt = (LAS float*)(F.lds + RING_OFF + attn_body::LDS_SCAN);
        const float bf = b_f[h];
        float ls[4]; float run = 0.f;
#pragma unroll
        for (int i = 0; i < 4; ++i) { const float x = flog[((size_t)b * SEQ + 4 * F.tid + i) * 16 + h] + bf; run += log_sigmoid_f(x); ls[i] = run; }
        float incl = run;
#pragma unroll
        for (int o = 1; o < 64; o <<= 1) { const float y = __shfl_up(incl, o); if (F.lane >= o) incl += y; }
        if (F.lane == 63) wt[F.wave] = incl;
        LDS_WAIT(); __syncthreads();
        float off = 0.f;
        for (int w = 0; w < F.wave; ++w) off += wt[w];
        const float excl = off + incl - run;
#pragma unroll
        for (int i = 0; i < 4; ++i) bt[4 * F.tid + i] = -(excl + ls[i]) * LOG2E;
        LDS_WAIT(); __syncthreads();
        for (int i = 0; i < attn_body::NQB; ++i)
            attn_body::attn_unit<8>(b, h, attn_body::NQB - 1 - i, (const attn_body::bf16*)Q, (const attn_body::bf16*)K, (const attn_body::bf16*)V, (attn_body::bf16*)O, (char*)lds_generic + RING_OFF);
        __syncthreads();
    }
}

__global__ void __launch_bounds__(NWAVES * 64, 2) yoco_fwd(Args args) {
    extern __shared__ __attribute__((aligned(16))) unsigned char lds[];
    Frame F;
    F.lds = (LAS unsigned char*)lds;
    F.MISC = (volatile LAS unsigned*)(F.lds + MISC_OFF);
    F.tid = threadIdx.x; F.lane = F.tid & 63; F.wave = __builtin_amdgcn_readfirstlane(F.tid >> 6);
    F.G = gridDim.x; { const int bx = blockIdx.x; F.vcu = (F.G % 8 == 0) ? (bx % 8) * (F.G / 8) + bx / 8 : bx; }
    unsigned char* ws = args.ws;
    F.ctl = (gu32*)(ws + WS_CTL);
    const int lo = args.lo, hi = args.hi;
    for (int u = F.tid; u < (LDS_BYTES - LDSCTL_OFF) / 4; u += NWAVES * 64) ((LAS unsigned*)(F.lds + LDSCTL_OFF))[u] = 0u;
    __syncthreads();
    XcdBarrier bar; bar.bar = (unsigned*)(F.ctl + CW_BAR); bar.x = 0; bar.st = nullptr;
    if (hi - lo > 1) bar = xcd_barrier_post((unsigned*)(F.ctl + CW_BAR), F.MISC + 8);
#define ON(s) (lo <= (s) && (s) < hi)
#define SEAM(s) do { if (lo <= (s) && (s) + 1 < hi) xcd_barrier(bar); } while (0)

    const float* x = args.in[0]; const float* attn_norm = args.in[1]; const float* ffn_norm = args.in[2]; const float* gla_w_in = args.in[3];
    const float* gla_g_head = args.in[6]; const float* gla_w_out = args.in[7];
    const float* kv_norm = args.in[8]; const float* w_kv = args.in[9]; const float* b_f = args.in[10]; const float* fox_w_q = args.in[11]; const float* fox_w_o = args.in[12];
    const float* ffn_w_gu = args.in[13]; const float* ffn_w_down = args.in[14]; const float* final_norm = args.in[15];
    float* out = args.out;
    float* part = (float*)(ws + WS_PART); float* skin = (float*)(ws + WS_SKIN); bf16* wsk = (bf16*)(ws + WS_WSK);
    bf16* Win_t = (bf16*)(ws + WS_WIN); bf16* Wout_t = (bf16*)(ws + WS_WOUT); bf16* Wgu_t = (bf16*)(ws + WS_WGU); bf16* Wdown_t = (bf16*)(ws + WS_WDOWN);
    bf16* Wkvq_t = (bf16*)(ws + WS_WKVQ); bf16* Wq3_t = (bf16*)(ws + WS_WQ3); bf16* Wo_t = (bf16*)(ws + WS_WO);
    bf16* hb = (bf16*)(ws + WS_HB); bf16* proj = (bf16*)(ws + WS_PROJ); bf16* oa = (bf16*)(ws + WS_OA);
    bf16* Kb = (bf16*)(ws + WS_K); bf16* Vb = (bf16*)(ws + WS_V); bf16* QO = (bf16*)(ws + WS_QO);

    if (ON(0)) {
        LAS float* scr = (LAS float*)(F.lds + RING_OFF + F.wave * 16384);
        const int gw = F.vcu * NWAVES + F.wave, NGW = F.G * NWAVES;
        constexpr int I_IN = (DM / 64) * (GPROJ / 32), I_SQ = (DM / 64) * (DM / 32), I_GU = (DM / 64) * (NGU / 32), I_DN = (DFF / 64) * (DM / 32), I_KV = (DM / 64) * (2048 / 32);
        constexpr int NITEMS = 2 * I_IN + 2 * I_SQ + 4 * I_GU + 4 * I_DN + I_KV + 2 * I_SQ + 2 * I_SQ;
        for (int it = gw; it < NITEMS; it += NGW) {
            int r = it;
            if (r < 2 * I_IN) { const int l = r / I_IN; r -= l * I_IN; p0_transpose_item(gla_w_in + (size_t)l * DM * GIN, GIN, 0, GPROJ, DM, attn_norm + l * DM, QSCALE_GLA, GQK, Win_t + (size_t)l * GPROJ * DM, 0, scr, r, F.lane); continue; } r -= 2 * I_IN;
            if (r < 2 * I_SQ) { const int l = r / I_SQ; r -= l * I_SQ; p0_transpose_item(gla_w_out + (size_t)l * DM * DM, DM, 0, DM, DM, nullptr, 1.f, 0, Wout_t + (size_t)l * DM * DM, 0, scr, r, F.lane); continue; } r -= 2 * I_SQ;
            if (r < 4 * I_GU) { const int l = r / I_GU; r -= l * I_GU; p0_transpose_item(ffn_w_gu + (size_t)l * DM * NGU, NGU, 0, NGU, DM, ffn_norm + l * DM, 1.f, 0, Wgu_t + (size_t)l * NGU * DM, 1, scr, r, F.lane); continue; } r -= 4 * I_GU;
            if (r < 4 * I_DN) { const int l = r / I_DN; r -= l * I_DN; p0_transpose_item(ffn_w_down + (size_t)l * DFF * DM, DM, 0, DM, DFF, nullptr, 1.f, 0, Wdown_t + (size_t)l * DM * DFF, 0, scr, r, F.lane); continue; } r -= 4 * I_DN;
            if (r < I_KV) { p0_transpose_item(w_kv, KVOUT, 0, 2048, DM, kv_norm, 1.f, 0, Wkvq_t, 0, scr, r, F.lane); continue; } r -= I_KV;
            if (r < 2 * I_SQ) { const int l = r / I_SQ; r -= l * I_SQ; p0_transpose_item(fox_w_q + (size_t)l * DM * DM, DM, 0, DM, DM, attn_norm + (2 + l) * DM, QSCALE_FOX, DM, l == 0 ? Wkvq_t + (size_t)2048 * DM : Wq3_t, 0, scr, r, F.lane); continue; } r -= 2 * I_SQ;
            { const int l = r / I_SQ; r -= l * I_SQ; p0_transpose_item(fox_w_o + (size_t)l * DM * DM, DM, 0, DM, DM, nullptr, 1.f, 0, Wo_t + (size_t)l * DM * DM, 0, scr, r, F.lane); }
        }
        for (int e = (F.vcu * NWAVES * 64 + F.tid); e < 3 * 16 * DM; e += F.G * NWAVES * 64) {
            const int j = e / (16 * DM), n = (e / DM) % 16, k = e % DM; float v;
            if (j < 2) v = gla_w_in[(size_t)j * DM * GIN + (size_t)k * GIN + GPROJ + n] * attn_norm[j * DM + k]; else v = w_kv[(size_t)k * KVOUT + 2048 + n] * kv_norm[k];
            wsk[e] = (bf16)f2bf(v);
        }
        for (int m = gw; m < MTOK; m += NGW) {
            const GAS f32x4* xr = (const GAS f32x4*)(x + (size_t)m * DM) + F.lane; f32x4 v[4]; float s = 0.f;
#pragma unroll
            for (int j = 0; j < 4; ++j) { v[j] = xr[64 * j]; s += (v[j][0] * v[j][0] + v[j][1] * v[j][1]) + (v[j][2] * v[j][2] + v[j][3] * v[j][3]); }
            s = wave_sum(s);
            GAS v2u* o8 = (GAS v2u*)(hb + (size_t)m * DM) + F.lane;
#pragma unroll
            for (int j = 0; j < 4; ++j) { v2u w; w.x = pk2(v[j][0], v[j][1]); w.y = pk2(v[j][2], v[j][3]); o8[64 * j] = w; }
            if (F.lane < 16) part[(size_t)m * 16 + F.lane] = (F.lane == 0) ? s : 0.f;
        }
    }
    SEAM(0);

    for (int l = 0; l < 2; ++l) {
        const int sb = 1 + 6 * l;
        const float* hin = (l == 0) ? x : out;
        if (ON(sb)) {
            skinny_phase(F, hb, wsk + (size_t)l * 16 * DM, part, skin);
            pg8::Gemm g{hb, Win_t + (size_t)l * GPROJ * DM, MTOK, GPROJ, DM}; pg8::StaticOrder S; S.init(MTOK, GPROJ, F.G, (int)blockIdx.x);
            pg8::EpiRowScaleBf16 E{proj, GPROJ, part, 0, 0};
            pg8::gemm_phase<pg8::EpiRowScaleBf16, pg8::StaticOrder, true, true>(F.lds + RING_OFF, g, S, E);
        }
        SEAM(sb);
        if (ON(sb + 1)) {   }
        SEAM(sb + 1);
        if (ON(sb + 2)) gate_phase(F, oa, proj, gla_g_head + l * GDV);
        SEAM(sb + 2);
        if (ON(sb + 3)) {
            pg8::Gemm g{oa, Wout_t + (size_t)l * DM * DM, MTOK, DM, DM}; pg8::StaticOrder S; S.init(MTOK, DM, F.G, (int)blockIdx.x);
            pg8::EpiResid E{hin, out, hb, part};
            pg8::gemm_phase<pg8::EpiResid, pg8::StaticOrder, true, true>(F.lds + RING_OFF, g, S, E);
        }
        SEAM(sb + 3);
        bf16* act = (bf16*)(ws + WS_ACT_GLA);
        if (ON(sb + 4)) {
            pg8::Gemm g{hb, Wgu_t + (size_t)l * NGU * DM, MTOK, NGU, DM}; pg8::StaticOrder S; S.init(MTOK, NGU, F.G, (int)blockIdx.x);
            pg8::EpiSwiglu E{act, DFF, part};
            pg8::gemm_phase<pg8::EpiSwiglu, pg8::StaticOrder, true, true>(F.lds + RING_OFF, g, S, E);
        }
        SEAM(sb + 4);
        if (ON(sb + 5)) {
            pg8::Gemm g{act, Wdown_t + (size_t)l * DM * DFF, MTOK, DM, DFF}; pg8::StaticOrder S; S.init(MTOK, DM, F.G, (int)blockIdx.x);
            pg8::EpiResid E{out, out, hb, part};
            pg8::gemm_phase<pg8::EpiResid, pg8::StaticOrder, true, true>(F.lds + RING_OFF, g, S, E);
        }
        SEAM(sb + 5);
    }

    for (int j = 0; j < 2; ++j) {
        const int sb = 13 + 5 * j;
        if (ON(sb)) {
            if (j == 0) {
                skinny_phase(F, hb, wsk + (size_t)2 * 16 * DM, part, skin);
                pg8::Gemm g{hb, Wkvq_t, MTOK, 3 * DM, DM}; pg8::StaticOrder S; S.init(MTOK, 3 * DM, F.G, (int)blockIdx.x);
                pg8::EpiRowScaleBf16 E{Kb, DM, part, DM, (size_t)MTOK * DM};
                pg8::gemm_phase<pg8::EpiRowScaleBf16, pg8::StaticOrder, true, true>(F.lds + RING_OFF, g, S, E);
            } else {
                pg8::Gemm g{hb, Wq3_t, MTOK, DM, DM}; pg8::StaticOrder S; S.init(MTOK, DM, F.G, (int)blockIdx.x);
                pg8::EpiRowScaleBf16 E{QO, DM, part, 0, 0};
                pg8::gemm_phase<pg8::EpiRowScaleBf16, pg8::StaticOrder, true, true>(F.lds + RING_OFF, g, S, E);
            }
        }
        SEAM(sb);
        if (ON(sb + 1)) {
#if !NAIVE_ATTN
            attn_phase(F, lds, skin, b_f, QO, Kb, Vb, QO);
#endif
        }
        SEAM(sb + 1);
        if (ON(sb + 2)) {
            pg8::Gemm g{QO, Wo_t + (size_t)j * DM * DM, MTOK, DM, DM}; pg8::StaticOrder S; S.init(MTOK, DM, F.G, (int)blockIdx.x);
            pg8::EpiResid E{out, out, hb, part};
            pg8::gemm_phase<pg8::EpiResid, pg8::StaticOrder, true, true>(F.lds + RING_OFF, g, S, E);
        }
        SEAM(sb + 2);
        bf16* act = (bf16*)(ws + WS_ACT_FOX);
        if (ON(sb + 3)) {
            pg8::Gemm g{hb, Wgu_t + (size_t)(2 + j) * NGU * DM, MTOK, NGU, DM}; pg8::StaticOrder S; S.init(MTOK, NGU, F.G, (int)blockIdx.x);
            pg8::EpiSwiglu E{act, DFF, part};
            pg8::gemm_phase<pg8::EpiSwiglu, pg8::StaticOrder, true, true>(F.lds + RING_OFF, g, S, E);
        }
        SEAM(sb + 3);
        if (ON(sb + 4)) {
            pg8::Gemm g{act, Wdown_t + (size_t)(2 + j) * DM * DFF, MTOK, DM, DFF}; pg8::StaticOrder S; S.init(MTOK, DM, F.G, (int)blockIdx.x);
            pg8::EpiResid E{out, out, hb, part};
            pg8::gemm_phase<pg8::EpiResid, pg8::StaticOrder, true, true>(F.lds + RING_OFF, g, S, E);
        }
        SEAM(sb + 4);
    }
    if (ON(23)) final_phase(F, out, part, final_norm);
#undef ON
#undef SEAM
}

__global__ void __launch_bounds__(256) naive_gla(const bf16* proj, const float* alow, const float* Wup, const float* balpha, bf16* o) {
    const int bh = blockIdx.x, b = bh / GH, h = bh % GH, tid = threadIdx.x;
    __shared__ float sq[128], sk[128], sal[128];
    float S[128];
#pragma unroll
    for (int d = 0; d < 128; ++d) S[d] = 0.f;
    float wup[16], bal = 0.f;
#pragma unroll
    for (int j = 0; j < 16; ++j) wup[j] = (tid < 128) ? Wup[j * GQK + h * GDK + tid] : 0.f;
    if (tid < 128) bal = balpha[h * GDK + tid];
    for (int t = 0; t < SEQ; ++t) {
        const size_t row = (size_t)b * SEQ + t;
        if (tid < 128) {
            float z = bal;
#pragma unroll
            for (int j = 0; j < 16; ++j) z += alow[row * 16 + j] * wup[j];
            sal[tid] = expf(log_sigmoid_f(z) * (1.0f / 16.0f));
            sq[tid] = bf2f(proj[row * GPROJ + h * GDK + tid]); sk[tid] = bf2f(proj[row * GPROJ + GQK + h * GDK + tid]);
        }
        __syncthreads();
        const float v = bf2f(proj[row * GPROJ + 2 * GQK + h * GDV + tid]);
        float acc = 0.f;
#pragma unroll
        for (int d = 0; d < 128; ++d) { S[d] = sal[d] * S[d] + sk[d] * v; acc += sq[d] * S[d]; }
        o[row * GV + h * GDV + tid] = (bf16)f2bf(acc);
        __syncthreads();
    }
}
__global__ void naive_cum(const float* flog, const float* b_f, float* c) {
    const int bh = blockIdx.x * blockDim.x + threadIdx.x; if (bh >= BATCH * FH) return;
    const int b = bh / FH, h = bh % FH; float run = 0.f;
    for (int t = 0; t < SEQ; ++t) { run += log_sigmoid_f(flog[((size_t)b * SEQ + t) * 16 + h] + b_f[h]); c[(size_t)bh * SEQ + t] = run; }
}
__global__ void __launch_bounds__(256) naive_attn(const bf16* Q, const bf16* K, const bf16* V, const float* c, bf16* O) {
    const int bh = blockIdx.y, b = bh / FH, h = bh % FH, t = blockIdx.x * 256 + threadIdx.x;
    float q[64], acc[64];
    const bf16* qp = Q + ((size_t)b * SEQ + t) * DM + h * FHD;
#pragma unroll
    for (int d = 0; d < 64; ++d) { q[d] = bf2f(qp[d]); acc[d] = 0.f; }
    const float* cb = c + (size_t)bh * SEQ; const float ct = cb[t];
    float m = -INFINITY, l = 0.f;
    for (int s = 0; s <= t; ++s) {
        const bf16* kp = K + ((size_t)b * SEQ + s) * DM + h * FHD; const bf16* vp = V + ((size_t)b * SEQ + s) * DM + h * FHD;
        float dot = 0.f;
#pragma unroll
        for (int d = 0; d < 64; ++d) dot += q[d] * bf2f(kp[d]);
        const float lg = dot + (ct - cb[s]) * LOG2E;
        const float mn = fmaxf(m, lg), al = exp2f(m - mn), p = exp2f(lg - mn);
        l = l * al + p;
#pragma unroll
        for (int d = 0; d < 64; ++d) acc[d] = acc[d] * al + p * bf2f(vp[d]);
        m = mn;
    }
    bf16* op = O + ((size_t)b * SEQ + t) * DM + h * FHD; const float rl = 1.0f / l;
#pragma unroll
    for (int d = 0; d < 64; ++d) op[d] = (bf16)f2bf(acc[d] * rl);
}

extern "C" void kernel_launch(void* const* d_in, const int* in_sizes, int n_in, void* d_out, int out_size, void* d_ws, size_t ws_size, hipStream_t stream) {
    static int grid = 0;
    if (grid == 0) {
        if (n_in != 16 || out_size != MTOK * DM || ws_size < WS_END) { fprintf(stderr, "kernel_launch: unexpected shapes (n_in %d, out %d, ws %zu)\n", n_in, out_size, ws_size); grid = -1; return; }
        int dev = 0, cus = 0, per_cu = 0;
        if (hipGetDevice(&dev) != hipSuccess || hipDeviceGetAttribute(&cus, hipDeviceAttributeMultiprocessorCount, dev) != hipSuccess) { grid = -1; return; }
        if (hipFuncSetAttribute((const void*)yoco_fwd, hipFuncAttributeMaxDynamicSharedMemorySize, LDS_BYTES) != hipSuccess) { fprintf(stderr, "kernel_launch: hipFuncSetAttribute failed\n"); grid = -1; return; }
        if (hipOccupancyMaxActiveBlocksPerMultiprocessor(&per_cu, (const void*)yoco_fwd, NWAVES * 64, LDS_BYTES) != hipSuccess || per_cu < 1) fprintf(stderr, "kernel_launch: occupancy query reports %d\n", per_cu);
        (void)hipGetLastError();
        grid = cus;
    }
    if (grid < 0) return;
    (void)hipMemsetAsync((char*)d_ws + WS_CTL, 0, CTL_ZERO_BYTES, stream);
    Args a{};
    for (int i = 0; i < 16; ++i) a.in[i] = (const float*)d_in[i];
    a.out = (float*)d_out; a.ws = (unsigned char*)d_ws;
    unsigned char* ws = (unsigned char*)d_ws;
#if KMODE == 1
    a.lo = 0; a.hi = 24;
    hipLaunchKernelGGL(yoco_fwd, dim3(grid), dim3(NWAVES * 64), LDS_BYTES, stream, a);
#else
    for (int s = 0; s < 24; ++s) {
        const bool is_scan = (s == 2 || s == 8), is_attn = (s == 14 || s == 19);
        if (is_scan && NAIVE_SCAN) {
            const int l = (s == 2) ? 0 : 1;
            hipLaunchKernelGGL(naive_gla, dim3(BATCH * GH), dim3(256), 0, stream, (const bf16*)(ws + WS_PROJ), (const float*)(ws + WS_SKIN),
                               (const float*)d_in[4] + (size_t)l * GRANK * GQK, (const float*)d_in[5] + (size_t)l * GQK, (bf16*)(ws + WS_OA));
            continue;
        }
        if (is_attn && NAIVE_ATTN) {
            hipLaunchKernelGGL(naive_cum, dim3(1), dim3(256), 0, stream, (const float*)(ws + WS_SKIN), (const float*)d_in[10], (float*)(ws + WS_CUM));
            hipLaunchKernelGGL(naive_attn, dim3(SEQ / 256, BATCH * FH), dim3(256), 0, stream, (const bf16*)(ws + WS_QO), (const bf16*)(ws + WS_K), (const bf16*)(ws + WS_V), (const float*)(ws + WS_CUM), (bf16*)(ws + WS_QO));
            continue;
        }
        a.lo = s; a.hi = s + 1;
        hipLaunchKernelGGL(yoco_fwd, dim3(grid), dim3(NWAVES * 64), LDS_BYTES, stream, a);
    }
#endif
}
```

```cpp
#include <hip/hip_runtime.h>
#include <hip/hip_bf16.h>
#include <cstdio>
#include <cstdint>
#include <cmath>

#ifndef KMODE
#define KMODE 1
#endif
#ifndef NAIVE_SCAN
#define NAIVE_SCAN 0
#endif
#ifndef NAIVE_ATTN
#define NAIVE_ATTN 0
#endif

constexpr int BATCH = 16, SEQ = 2048, DM = 1024, MTOK = BATCH * SEQ;
constexpr int GH = 4, GDK = 128, GDV = 256, GQK = 512, GV = 1024, GRANK = 16, GIN = 3088, GPROJ = 3072;
constexpr int FH = 16, FHD = 64, KVOUT = 2064;
constexpr int DFF = 2816, NGU = 2 * DFF;
constexpr float EPS = 1e-6f;
constexpr float LOG2E = 1.4426950408889634f;
constexpr float QSCALE_GLA = 0.08838834764831845f;
constexpr float QSCALE_FOX = 0.125f * LOG2E;

namespace pg8 {
#define PG8_LAS __attribute__((address_space(3)))
typedef unsigned short bf16_t;
typedef short bf16x8 __attribute__((ext_vector_type(8)));
typedef float f32x4 __attribute__((ext_vector_type(4)));
typedef unsigned u32x4 __attribute__((ext_vector_type(4)));
typedef unsigned u32x2 __attribute__((ext_vector_type(2)));
constexpr int BM = 256, BK = 64, HALF = 128, HTB = HALF * BK * 2, STAGE_BYTES = 8 * HTB, NXCD = 8, WGM = 8;

__host__ __device__ __forceinline__ int lds_byte(int r, int c) { const int st = (r >> 4) * 2 + (c >> 5), rr = r & 15, cc = c & 31, ob = rr * 64 + cc * 2; return st * 1024 + (ob ^ (((ob >> 9) & 1) << 5)); }
__host__ __device__ __forceinline__ void stage_rc(int b, int& R, int& C) { const int st = b / 1024, sb = b % 1024, swz = sb ^ (((sb >> 9) & 1) << 5); R = (st >> 1) * 16 + swz / 64; C = (st & 1) * 32 + (swz % 64) / 2; }
__host__ __device__ __forceinline__ int perm32(int rho) { const int n = rho >> 4, i = rho & 15; return 8 * (i >> 2) + 4 * n + (i & 3); }

struct Unit { int pm, pn; };
struct Gemm { const bf16_t* A; const bf16_t* Bt; int M, N, K; };

struct StaticOrder {
    int nM, nN, nwg, G, c;
    __host__ __device__ void init(int M, int N, int G_, int c_) { nM = M / BM; nN = N / BM; nwg = nM * nN; G = G_; c = c_; }
    __host__ __device__ bool next(int i, Unit& u) const {
        const long L = (long)i * G + c; if (L >= nwg) return false;
        int wgid = (int)L; { const int q = nwg / NXCD, r = nwg % NXCD, xcd = wgid % NXCD, off = wgid / NXCD; wgid = (xcd < r ? xcd * (q + 1) : r * (q + 1) + (xcd - r) * q) + off; }
        const int nig = WGM * nN, gid = wgid / nig, fm = gid * WGM, gsz = (nM - fm) < WGM ? (nM - fm) : WGM;
        u.pm = fm + ((wgid % nig) % gsz); u.pn = (wgid % nig) / gsz; return true;
    }
    __device__ __forceinline__ void a_ready(const Unit&) const {}
    __device__ __forceinline__ void done(const Unit&) const {}
};

__device__ __forceinline__ unsigned cvt_pk_bf16(float lo, float hi) { unsigned r; asm volatile("v_cvt_pk_bf16_f32 %0, %1, %2" : "=v"(r) : "v"(lo), "v"(hi)); return r; }

__device__ __forceinline__ float rstd_row(const float* part, int row) {
    const f32x4* p = (const f32x4*)(part + (size_t)row * 16);
    const f32x4 a = p[0], b = p[1], c = p[2], d = p[3];
    const float s = (((a[0] + a[1]) + (a[2] + a[3])) + ((b[0] + b[1]) + (b[2] + b[3]))) + (((c[0] + c[1]) + (c[2] + c[3])) + ((d[0] + d[1]) + (d[2] + d[3])));
    return 1.0f / sqrtf(s * (1.0f / 1024.0f) + EPS);
}
__device__ __forceinline__ float silu_f(float x) { return x * __builtin_amdgcn_rcpf(1.0f + __builtin_amdgcn_exp2f(-x * LOG2E)); }

struct EpiRowScaleBf16 {
    static constexpr bool PERM = true, AFTER_DRAIN = false;
    bf16_t* O; int ldc; const float* part; int split_cols; size_t split_stride;
    __device__ __forceinline__ void operator()(const f32x4 (&acc)[2][2][4][2], const Unit& u, int wr, int wc, int fr, int fq) const {
        const int row0 = u.pm * BM + wr * 64 + fr; int colt = u.pn * BM; bf16_t* base = O;
        if (split_cols) { const int t = colt / split_cols; base += (size_t)t * split_stride; colt -= t * split_cols; }
        const int col0 = colt + wc * 32 + 8 * fq;
#pragma unroll
        for (int ai = 0; ai < 2; ++ai)
#pragma unroll
            for (int m = 0; m < 4; ++m) { const int row = row0 + ai * HALF + m * 16; const float rs = rstd_row(part, row); bf16_t* rowp = base + (size_t)row * ldc + col0;
#pragma unroll
                for (int bj = 0; bj < 2; ++bj) { const f32x4 v0 = acc[ai][bj][m][0] * rs, v1 = acc[ai][bj][m][1] * rs;
                    u32x4 w; w.x = cvt_pk_bf16(v0[0], v0[1]); w.y = cvt_pk_bf16(v0[2], v0[3]); w.z = cvt_pk_bf16(v1[0], v1[1]); w.w = cvt_pk_bf16(v1[2], v1[3]);
                    *(u32x4*)(rowp + bj * HALF) = w; }
                asm volatile("" ::: "memory"); }
    }
};
struct EpiSwiglu {
    static constexpr bool PERM = true, AFTER_DRAIN = false;
    bf16_t* O; int ldc; const float* part;
    __device__ __forceinline__ void operator()(const f32x4 (&acc)[2][2][4][2], const Unit& u, int wr, int wc, int fr, int fq) const {
        const int row0 = u.pm * BM + wr * 64 + fr; const int col0 = u.pn * HALF + wc * 32 + 8 * fq;
#pragma unroll
        for (int ai = 0; ai < 2; ++ai)
#pragma unroll
            for (int m = 0; m < 4; ++m) { const int row = row0 + ai * HALF + m * 16; const float rs = rstd_row(part, row);
                const f32x4 g0 = acc[ai][0][m][0] * rs, g1 = acc[ai][0][m][1] * rs, u0 = acc[ai][1][m][0] * rs, u1 = acc[ai][1][m][1] * rs;
                float a[8];
#pragma unroll
                for (int i = 0; i < 4; ++i) { a[i] = silu_f(g0[i]) * u0[i]; a[4 + i] = silu_f(g1[i]) * u1[i]; }
                u32x4 w; w.x = cvt_pk_bf16(a[0], a[1]); w.y = cvt_pk_bf16(a[2], a[3]); w.z = cvt_pk_bf16(a[4], a[5]); w.w = cvt_pk_bf16(a[6], a[7]);
                *(u32x4*)(O + (size_t)row * ldc + col0) = w;
                asm volatile("" ::: "memory"); }
    }
};
struct EpiResid {
    static constexpr bool PERM = false, AFTER_DRAIN = false;
    const float* base; float* out; bf16_t* hb; float* part_out;
    __device__ __forceinline__ void operator()(const f32x4 (&acc)[2][2][4][2], const Unit& u, int wr, int wc, int fr, int fq) const {
        const int row0 = u.pm * BM + wr * 64 + fr, col0 = u.pn * BM + wc * 32 + 4 * fq;
#pragma unroll
        for (int ai = 0; ai < 2; ++ai)
#pragma unroll
            for (int m = 0; m < 4; ++m) { const int row = row0 + ai * HALF + m * 16; const size_t off = (size_t)row * DM + col0; float ss = 0.f;
#pragma unroll
                for (int bj = 0; bj < 2; ++bj)
#pragma unroll
                    for (int n = 0; n < 2; ++n) { const f32x4 bs = *(const f32x4*)(base + off + bj * HALF + n * 16); const f32x4 o = bs + acc[ai][bj][m][n];
                        *(f32x4*)(out + off + bj * HALF + n * 16) = o; ss += (o[0] * o[0] + o[1] * o[1]) + (o[2] * o[2] + o[3] * o[3]);
                        u32x2 w; w.x = cvt_pk_bf16(o[0], o[1]); w.y = cvt_pk_bf16(o[2], o[3]); *(u32x2*)(hb + off + bj * HALF + n * 16) = w; }
                ss += __shfl_xor(ss, 16); ss += __shfl_xor(ss, 32);
                if (fq == 0) part_out[(size_t)row * 16 + u.pn * 4 + wc] = ss;
                asm volatile("" ::: "memory"); }
    }
};

template <class Epi, class Sched, bool ALIGN_EPI = false, bool SP2 = false>
__device__ __forceinline__ void gemm_phase(PG8_LAS unsigned char* lds, const Gemm g, const Sched& S, const Epi& E) {
    int tid_ = threadIdx.x; asm volatile("" : "+v"(tid_));
    const int tid = tid_, wid = __builtin_amdgcn_readfirstlane(tid >> 6), lane = tid & 63, wr = wid >> 2, wc = wid & 3, fr = lane & 15, fq = lane >> 4;
    const int K = g.K, nt = K / BK;
    unsigned voffA[2], voffB[2];
#pragma unroll
    for (int i = 0; i < 2; ++i) { int R, C; stage_rc(tid * 16 + i * 8192, R, C); const int Rb = Epi::PERM ? ((R & ~31) + perm32(R & 31)) : R;
        voffA[i] = (unsigned)(R * K + C) * 2u; voffB[i] = (unsigned)(Rb * K + C) * 2u; }
    const size_t kstep = (size_t)(BK * 2);
    const size_t hstep = (size_t)HALF * K * 2;
    const size_t tstep = 2 * hstep;
    const unsigned ldsw = (unsigned)wid * 1024u;
    const int aoff = lds_byte(wr * 64 + fr, fq * 8), boff = lds_byte(wc * 32 + fr, fq * 8);
#define PG8_SA(b, h) (((b) * 2 + (h)) * HTB)
#define PG8_SB(b, h) ((4 + (b) * 2 + (h)) * HTB)
#define PG8_STAGE(bufoff, gbase, voff) do { _Pragma("unroll") for (int _i = 0; _i < 2; ++_i) \
        __builtin_amdgcn_global_load_lds((const unsigned*)((const char*)(gbase) + (voff)[_i]), (PG8_LAS unsigned*)(lds + (bufoff) + ldsw + _i * 8192), 16, 0, 0); } while (0)
#define PG8_LDA(dst, b, h) do { _Pragma("unroll") for (int m = 0; m < 4; ++m) _Pragma("unroll") for (int k = 0; k < 2; ++k) dst[m][k] = *(const PG8_LAS bf16x8*)(lds + PG8_SA(b, h) + aoff + m * 2048 + k * 1024); } while (0)
#define PG8_LDB(dst, b, h) do { _Pragma("unroll") for (int n = 0; n < 2; ++n) _Pragma("unroll") for (int k = 0; k < 2; ++k) dst[n][k] = *(const PG8_LAS bf16x8*)(lds + PG8_SB(b, h) + boff + n * 2048 + k * 1024); } while (0)
#define PG8_MMA(ai, bj, At, Bt) do { __builtin_amdgcn_s_setprio(1); _Pragma("unroll") for (int m = 0; m < 4; ++m) _Pragma("unroll") for (int n = 0; n < 2; ++n) _Pragma("unroll") for (int k = 0; k < 2; ++k) \
        acc[ai][bj][m][n] = __builtin_amdgcn_mfma_f32_16x16x32_bf16(Bt[n][k], At[m][k], acc[ai][bj][m][n], 0, 0, 0); __builtin_amdgcn_s_setprio(0); } while (0)
#define PG8_WAIT_V(n) asm volatile("s_waitcnt vmcnt(" #n ")" ::: "memory")
#define PG8_WAIT_L(n) asm volatile("s_waitcnt lgkmcnt(" #n ")" ::: "memory")
#define PG8_BAR __builtin_amdgcn_s_barrier()
#define PG8_SCHED __builtin_amdgcn_sched_barrier(0)
    Unit cur, nxt; int ui = 0;
    if (!S.next(0, cur)) return;
    f32x4 acc[2][2][4][2];
#pragma unroll
    for (int a = 0; a < 2; ++a)
#pragma unroll
        for (int b = 0; b < 2; ++b)
#pragma unroll
            for (int m = 0; m < 4; ++m)
#pragma unroll
                for (int n = 0; n < 2; ++n) acc[a][b][m][n] = (f32x4){0.f, 0.f, 0.f, 0.f};
    bf16x8 At[4][2], B0[2][2], B1[2][2];
    const char* cA = (const char*)g.A + (size_t)cur.pm * tstep; const char* cB = (const char*)g.Bt + (size_t)cur.pn * tstep;
    S.a_ready(cur);
    if constexpr (SP2) {
        PG8_STAGE(PG8_SB(0, 0), cB, voffB); PG8_STAGE(PG8_SB(0, 1), cB + hstep, voffB); PG8_STAGE(PG8_SA(0, 0), cA, voffA); PG8_STAGE(PG8_SA(0, 1), cA + hstep, voffA);
        if (wr == 1) PG8_BAR;
        PG8_WAIT_V(2); PG8_BAR;
        PG8_STAGE(PG8_SB(1, 0), cB + kstep, voffB); PG8_STAGE(PG8_SA(1, 0), cA + kstep, voffA); PG8_STAGE(PG8_SB(1, 1), cB + hstep + kstep, voffB);
        PG8_WAIT_V(6); PG8_BAR;
    } else {
        PG8_STAGE(PG8_SB(0, 0), cB, voffB); PG8_STAGE(PG8_SA(0, 0), cA, voffA); PG8_STAGE(PG8_SB(0, 1), cB + hstep, voffB); PG8_STAGE(PG8_SA(0, 1), cA + hstep, voffA);
        if (wr == 1) PG8_BAR;
        PG8_WAIT_V(4); PG8_BAR;
        PG8_STAGE(PG8_SB(1, 0), cB + kstep, voffB); PG8_STAGE(PG8_SA(1, 0), cA + kstep, voffA); PG8_STAGE(PG8_SB(1, 1), cB + hstep + kstep, voffB);
        PG8_WAIT_V(6); PG8_BAR;
    }
    for (;;) {
        const bool has_next = S.next(ui + 1, nxt);
        const char* nA = has_next ? (const char*)g.A + (size_t)nxt.pm * tstep : cA; const char* nB = has_next ? (const char*)g.Bt + (size_t)nxt.pn * tstep : cB;
        for (int t = 0; t < nt; t += 2) {
            const bool last = (t == nt - 2);
            const char* a1 = cA + (size_t)(t + 1) * kstep;
            const char* a2 = last ? nA : cA + (size_t)(t + 2) * kstep; const char* b2 = last ? nB : cB + (size_t)(t + 2) * kstep;
            const char* a3 = a2 + kstep; const char* b3 = b2 + kstep;
            if (last && has_next) S.a_ready(nxt);
            if constexpr (SP2) {
            PG8_LDB(B0, 0, 0); PG8_LDB(B1, 0, 1); PG8_SCHED; PG8_LDA(At, 0, 0); PG8_STAGE(PG8_SA(1, 1), a1 + hstep, voffA);
            PG8_WAIT_V(8); PG8_WAIT_L(0); PG8_BAR; PG8_MMA(0, 0, At, B0); PG8_MMA(0, 1, At, B1); PG8_BAR; PG8_SCHED;
            PG8_LDA(At, 0, 1); PG8_STAGE(PG8_SB(0, 0), b2, voffB); PG8_STAGE(PG8_SB(0, 1), b2 + hstep, voffB); PG8_STAGE(PG8_SA(0, 0), a2, voffA);
            PG8_WAIT_V(8); PG8_WAIT_L(0); PG8_BAR; PG8_MMA(1, 0, At, B0); PG8_MMA(1, 1, At, B1); PG8_BAR; PG8_SCHED;
            PG8_LDB(B0, 1, 0); PG8_LDB(B1, 1, 1); PG8_SCHED; PG8_LDA(At, 1, 0); PG8_STAGE(PG8_SA(0, 1), a2 + hstep, voffA);
            PG8_WAIT_V(8); PG8_WAIT_L(0); PG8_BAR; PG8_MMA(0, 0, At, B0); PG8_MMA(0, 1, At, B1); PG8_BAR; PG8_SCHED;
            PG8_LDA(At, 1, 1); PG8_STAGE(PG8_SB(1, 0), b3, voffB); PG8_STAGE(PG8_SB(1, 1), b3 + hstep, voffB); PG8_STAGE(PG8_SA(1, 0), a3, voffA);
            PG8_WAIT_V(8); PG8_WAIT_L(0); PG8_BAR; PG8_MMA(1, 0, At, B0); PG8_MMA(1, 1, At, B1); PG8_BAR; PG8_SCHED;
            } else {
            PG8_LDB(B0, 0, 0); PG8_SCHED; PG8_LDA(At, 0, 0); PG8_STAGE(PG8_SA(1, 1), a1 + hstep, voffA);
            PG8_WAIT_L(8); PG8_BAR; PG8_WAIT_L(0); PG8_MMA(0, 0, At, B0); PG8_BAR; PG8_SCHED;
            PG8_LDB(B1, 0, 1); PG8_STAGE(PG8_SB(0, 0), b2, voffB);
            PG8_BAR; PG8_WAIT_L(0); PG8_MMA(0, 1, At, B1); PG8_BAR;
            PG8_LDA(At, 0, 1); PG8_STAGE(PG8_SA(0, 0), a2, voffA);
            PG8_BAR; PG8_WAIT_L(0); PG8_MMA(1, 0, At, B0); PG8_BAR; PG8_SCHED;
            PG8_STAGE(PG8_SB(0, 1), b2 + hstep, voffB);
            PG8_WAIT_V(6); PG8_BAR; PG8_MMA(1, 1, At, B1); PG8_BAR;
            PG8_LDB(B0, 1, 0); PG8_SCHED; PG8_LDA(At, 1, 0); PG8_STAGE(PG8_SA(0, 1), a2 + hstep, voffA);
            PG8_WAIT_L(8); PG8_BAR; PG8_WAIT_L(0); PG8_MMA(0, 0, At, B0); PG8_BAR; PG8_SCHED;
            PG8_LDB(B1, 1, 1); PG8_STAGE(PG8_SB(1, 0), b3, voffB);
            PG8_BAR; PG8_WAIT_L(0); PG8_MMA(0, 1, At, B1); PG8_BAR;
            PG8_LDA(At, 1, 1); PG8_STAGE(PG8_SA(1, 0), a3, voffA);
            PG8_BAR; PG8_WAIT_L(0); PG8_MMA(1, 0, At, B0); PG8_BAR; PG8_SCHED;
            PG8_STAGE(PG8_SB(1, 1), b3 + hstep, voffB);
            PG8_WAIT_V(6); PG8_BAR; PG8_MMA(1, 1, At, B1); PG8_BAR;
            }
        }
        if constexpr (ALIGN_EPI) { if (wr == 0) PG8_BAR; }
        if constexpr (!Epi::AFTER_DRAIN) { E(acc, cur, wr, wc, fr, fq); S.done(cur); }
        if (!has_next) break;
#pragma unroll
        for (int a = 0; a < 2; ++a)
#pragma unroll
            for (int b = 0; b < 2; ++b)
#pragma unroll
                for (int m = 0; m < 4; ++m)
#pragma unroll
                    for (int n = 0; n < 2; ++n) acc[a][b][m][n] = (f32x4){0.f, 0.f, 0.f, 0.f};
        cur = nxt; cA = nA; cB = nB; ++ui;
        if constexpr (ALIGN_EPI) { if (wr == 1) PG8_BAR; }
    }
    PG8_WAIT_V(0);
    if constexpr (!ALIGN_EPI) { if (wr == 0) PG8_BAR; }
    PG8_BAR;
#undef PG8_SA
#undef PG8_SB
#undef PG8_STAGE
#undef PG8_LDA
#undef PG8_LDB
#undef PG8_MMA
#undef PG8_WAIT_V
#undef PG8_WAIT_L
#undef PG8_BAR
#undef PG8_SCHED
}
}

namespace attn_body {
using bf16=__hip_bfloat16;
using bf16x8=__attribute__((ext_vector_type(8)))short;
using s16x4=__attribute__((ext_vector_type(4)))short;
using f32x16=__attribute__((ext_vector_type(16)))float;
using f32x4=__attribute__((ext_vector_type(4)))float;
using u32x4=__attribute__((ext_vector_type(4)))unsigned;
constexpr int NHEAD=16,D=64,DMA=NHEAD*D;
constexpr int NW=8,QBLK=32,QB=QBLK*NW,KVBLK=64,NQB=SEQ/QB;
__device__ __forceinline__ int crow(int r,int hi){return (r&3)+8*(r>>2)+4*hi;}
#define SBAR() __builtin_amdgcn_sched_barrier(0)
__device__ __forceinline__ void cmask(f32x16&p0,f32x16&p1,int jb,int qrel,int hi){
  const float NEG=-INFINITY; int kb=64*jb+4*hi;
  #pragma unroll
  for(int r=0;r<16;++r){int kv=kb+(r&3)+8*(r>>2); if(kv>qrel)p0[r]=NEG; if(kv+32>qrel)p1[r]=NEG;}
}
constexpr int NSLOT=3, SLOTB=8192;
constexpr int LDS_K=0, LDS_V=NSLOT*SLOTB, LDS_WS=2*NSLOT*SLOTB, LDS_OST=LDS_WS+NW*64*4, LDS_BYTES=LDS_OST+NW*4096;
constexpr int LDS_BIAS=LDS_BYTES, LDS_BIAS_BYTES=SEQ*4, LDS_SCAN=LDS_BIAS+LDS_BIAS_BYTES, LDS_TOTAL=LDS_SCAN+64;
__device__ __forceinline__ void glds16(const void*gsrc,unsigned lds_dst){unsigned keep;
  asm volatile("s_mov_b32 %0, m0\n\ts_mov_b32 m0, %2\n\ts_nop 0\n\tglobal_load_lds_dwordx4 %1, off\n\ts_mov_b32 m0, %0":"=&s"(keep):"v"(gsrc),"s"(lds_dst):"memory");}
__device__ __forceinline__ float max3f(float a,float b,float c){float r;asm("v_max3_f32 %0, %1, %2, %3":"=v"(r):"v"(a),"v"(b),"v"(c));return r;}
__device__ __forceinline__ float max2f(float a,float b){float r;asm("v_max_f32_e32 %0, %1, %2":"=v"(r):"v"(a),"v"(b));return r;}
__device__ __forceinline__ float fadd_s(float a,float b){float r;asm("v_add_f32_e32 %0, %1, %2":"=v"(r):"v"(a),"v"(b));return r;}
__device__ __forceinline__ float fsub_s(float a,float b){float r;asm("v_sub_f32_e32 %0, %1, %2":"=v"(r):"v"(a),"v"(b));return r;}
typedef float f32x2_t __attribute__((ext_vector_type(2))); typedef __bf16 bf16x2_t __attribute__((ext_vector_type(2)));
__device__ __forceinline__ unsigned cvtpk_s(float lo,float hi){f32x2_t v={lo,hi};bf16x2_t b=__builtin_convertvector(v,bf16x2_t);return __builtin_bit_cast(unsigned,b);}
#define WAIT_BAR(N) asm volatile("s_waitcnt vmcnt(" #N ") lgkmcnt(0)\n\ts_barrier":::"memory")

__device__ __forceinline__ void qkt(f32x16&p0,f32x16&p1,const char*Kslot,const bf16x8*qr,int r32,int hi){
  const f32x16 negm=f32x16{};
  const char*kb=Kslot+hi*1024+r32*16;
  #pragma unroll
  for(int d0=0;d0<4;++d0){
    const bf16x8 b0=*reinterpret_cast<const bf16x8*>(kb+d0*2048);
    const bf16x8 b1=*reinterpret_cast<const bf16x8*>(kb+d0*2048+512);
    if(d0==0){p0=__builtin_amdgcn_mfma_f32_32x32x16_bf16(b0,qr[0],negm,0,0,0);p1=__builtin_amdgcn_mfma_f32_32x32x16_bf16(b1,qr[0],negm,0,0,0);}
    else{p0=__builtin_amdgcn_mfma_f32_32x32x16_bf16(b0,qr[d0],p0,0,0,0);p1=__builtin_amdgcn_mfma_f32_32x32x16_bf16(b1,qr[d0],p1,0,0,0);}}
}
typedef __attribute__((address_space(3))) const char* lds_cptr;
typedef short v4i16_t __attribute__((ext_vector_type(4)));
__device__ __forceinline__ void kload8(bf16x8*kf,lds_cptr kp){
  kf[0]=*(const __attribute__((address_space(3))) bf16x8*)(kp);      kf[1]=*(const __attribute__((address_space(3))) bf16x8*)(kp+512);
  kf[2]=*(const __attribute__((address_space(3))) bf16x8*)(kp+2048); kf[3]=*(const __attribute__((address_space(3))) bf16x8*)(kp+2560);
  kf[4]=*(const __attribute__((address_space(3))) bf16x8*)(kp+4096); kf[5]=*(const __attribute__((address_space(3))) bf16x8*)(kp+4608);
  kf[6]=*(const __attribute__((address_space(3))) bf16x8*)(kp+6144); kf[7]=*(const __attribute__((address_space(3))) bf16x8*)(kp+6656);
}
__device__ __forceinline__ void kload2(bf16x8*kf,lds_cptr kp,int j){ kf[2*j]=*(const __attribute__((address_space(3))) bf16x8*)(kp+j*2048); kf[2*j+1]=*(const __attribute__((address_space(3))) bf16x8*)(kp+j*2048+512); }
__device__ __forceinline__ s16x4 vtr(lds_cptr p){ return __builtin_bit_cast(s16x4,__builtin_amdgcn_ds_read_tr16_b64_v4i16((__attribute__((address_space(3))) v4i16_t*)p)); }
__device__ __forceinline__ float rowmax(const f32x16&p0,const f32x16&p1){
  float a=max3f(p0[0],p0[1],p1[0]),b=max3f(p0[2],p0[3],p1[1]);a=max3f(a,p1[2],p1[3]);
  #pragma unroll
  for(int r=4;r<16;r+=4){a=max3f(a,p0[r],p0[r+1]);b=max3f(b,p0[r+2],p0[r+3]);a=max3f(a,p1[r],p1[r+1]);b=max3f(b,p1[r+2],p1[r+3]);}
  const float m=max2f(a,b);
  auto rr=__builtin_amdgcn_permlane32_swap(__float_as_uint(m),__float_as_uint(m),false,false);
  return max2f(__uint_as_float(rr[0]),__uint_as_float(rr[1]));
}
__device__ __forceinline__ void pv(f32x16*o,int vb,bf16x8 pa0,bf16x8 pa1,bf16x8 pa2,bf16x8 pa3){
  #pragma unroll
  for(int d0=0;d0<2;++d0){s16x4 lo[4],hi[4];
    #pragma unroll
    for(int ks=0;ks<4;++ks){
      asm volatile("ds_read_b64_tr_b16 %0,%1 offset:%c2":"=&v"(lo[ks]):"v"(vb),"i"(d0*4096+ks*1024):"memory");
      asm volatile("ds_read_b64_tr_b16 %0,%1 offset:%c2":"=&v"(hi[ks]):"v"(vb),"i"(d0*4096+ks*1024+512):"memory");}
    asm volatile("s_waitcnt lgkmcnt(0)":::"memory");SBAR();
    #define PK(k) (bf16x8){lo[k][0],lo[k][1],lo[k][2],lo[k][3],hi[k][0],hi[k][1],hi[k][2],hi[k][3]}
    o[d0]=__builtin_amdgcn_mfma_f32_32x32x16_bf16(pa0,PK(0),o[d0],0,0,0);
    o[d0]=__builtin_amdgcn_mfma_f32_32x32x16_bf16(pa1,PK(1),o[d0],0,0,0);
    o[d0]=__builtin_amdgcn_mfma_f32_32x32x16_bf16(pa2,PK(2),o[d0],0,0,0);
    o[d0]=__builtin_amdgcn_mfma_f32_32x32x16_bf16(pa3,PK(3),o[d0],0,0,0);
    #undef PK
  }
}
__device__ __forceinline__ void kbias(f32x16&p0,f32x16&p1,const __attribute__((address_space(3))) float*bt,int t,int hi,float mh){
  const __attribute__((address_space(3))) f32x4*b4=(const __attribute__((address_space(3))) f32x4*)(bt+64*t+4*hi);
  #pragma unroll
  for(int g=0;g<4;++g){ const f32x4 x=b4[2*g], y=b4[2*g+8];
    #pragma unroll
    for(int i=0;i<4;++i){p0[4*g+i]+=x[i]-mh;p1[4*g+i]+=y[i]-mh;} }
}

#ifndef ATTN_STORE16
#define ATTN_STORE16(p,v) (*(u32x4*)(p)=(v))
#endif
template<int THRL> __device__ __forceinline__ void attn_unit(int b,int h,int qb,const bf16*Q,const bf16*__restrict__ K,const bf16*__restrict__ V,bf16*O,char*shm){
  int tid_=threadIdx.x; asm volatile("":"+v"(tid_));
  const int tid=tid_,lane=tid&63,r32=lane&31,hi=lane>>5; const int wid=__builtin_amdgcn_readfirstlane(tid>>6);
  const long rowbase=(long)b*SEQ; const int q0=qb*QB;
  const bf16*Qw=Q+(rowbase+q0+wid*QBLK)*DMA+h*D;
  const bf16*Kh=K+rowbase*DMA+h*D,*Vh=V+rowbase*DMA+h*D;
  const unsigned lds0=(unsigned)(uintptr_t)shm;
  float*wsf=(float*)(shm+LDS_WS)+wid*64;
  const __attribute__((address_space(3))) float*bt=(const __attribute__((address_space(3))) float*)((lds_cptr)shm+LDS_BIAS);
  const bf16*ksrc=Kh+(long)lane*DMA+wid*8;
  const bf16*vsrc=Vh+(long)(16*(wid&3)+(lane>>2))*DMA+(wid>>2)*32+(lane&3)*8;
  const unsigned kdst=lds0+LDS_K+wid*1024, vdst=lds0+LDS_V+wid*1024;
  #define DMA_K(t,slot) glds16(ksrc+(long)(t)*KVBLK*DMA,(unsigned)__builtin_amdgcn_readfirstlane(kdst+(slot)))
  #define DMA_V(t,slot) glds16(vsrc+(long)(t)*KVBLK*DMA,(unsigned)__builtin_amdgcn_readfirstlane(vdst+(slot)))
  const int vb0=(int)(lds0+LDS_V)+((lane>>4)&1)*32+(lane&3)*8+(4*hi+((lane&15)>>2))*64;
  const char*Kbase=shm+LDS_K; bf16x8 kf[8];
  const lds_cptr shm3=(lds_cptr)shm; const lds_cptr kp0=shm3+LDS_K+hi*1024+r32*16; const lds_cptr vp0=shm3+LDS_V+((lane>>4)&1)*32+(lane&3)*8+(4*hi+((lane&15)>>2))*64;
  const int NT=(q0+QB)/KVBLK;
  DMA_K(0,0);DMA_V(0,0);DMA_K(1,SLOTB);
  bf16x8 qr[4];
  #pragma unroll
  for(int d0=0;d0<4;++d0)qr[d0]=*reinterpret_cast<const bf16x8*>(&Qw[(long)r32*DMA+d0*16+hi*8]);
  const int qrel=wid*QBLK+r32;
  float mhat=bt[q0+qrel],l_reg=0.f;f32x16 o[2];o[0]=f32x16{};o[1]=f32x16{};
  const f32x16 zero16=f32x16{};
  #define CMASK(P0,P1,t) do{int jb_=(t)-(NT-4); if(jb_>=0)cmask(P0,P1,jb_,qrel,hi);}while(0)
  bool resc=false;
  #define START(P0,P1) do{ const float rm=rowmax(P0,P1); resc=false; \
    { const float dl=rm; mhat=fadd_s(mhat,dl); \
      _Pragma("unroll") for(int r=0;r<16;++r){P0[r]=fsub_s(P0[r],dl);P1[r]=fsub_s(P1[r],dl);} } \
    _Pragma("unroll") for(int r=0;r<16;++r)P0[r]=__builtin_amdgcn_exp2f(P0[r]); }while(0)
  #define RESC() do{ if(resc){ asm volatile("s_waitcnt lgkmcnt(0)":::"memory"); \
      _Pragma("unroll") for(int d_=0;d_<2;++d_) _Pragma("unroll") for(int r=0;r<16;++r)o[d_][r]*=wsf[crow(r,hi)]; } }while(0)
  f32x16 pA0,pA1,pB0,pB1;
  int sl_prev=0,sl_cur=0,sl_next=SLOTB;
  #define ROT() do{sl_prev=sl_cur;sl_cur=sl_next;sl_next=(sl_next==(NSLOT-1)*SLOTB)?0:sl_next+SLOTB;}while(0)
  DMA_K(2,2*SLOTB);
  WAIT_BAR(3);
  qkt(pA0,pA1,Kbase,qr,r32,hi);asm volatile("s_nop 15\n\ts_nop 7":"+v"(pA0),"+v"(pA1));kbias(pA0,pA1,bt,0,hi,mhat);CMASK(pA0,pA1,0);
  START(pA0,pA1);
  _Pragma("unroll") for(int r=0;r<16;++r)pA1[r]=__builtin_amdgcn_exp2f(pA1[r]);
  WAIT_BAR(0);
  DMA_K(3,0);DMA_V(1,SLOTB);
  ROT();
  kload8(kf,kp0+sl_cur);
  WAIT_BAR(2);
  s16x4 vlo[8],vhi[8]; u32x4 pw0,pw1,pw2,pw3;
  #define PKW(P,B) cvtpk_s(P[B],P[B+1])
  #define PAF(k) __builtin_bit_cast(bf16x8,pw##k)
  #define VFR(i) (bf16x8){vlo[i][0],vlo[i][1],vlo[i][2],vlo[i][3],vhi[i][0],vhi[i][1],vhi[i][2],vhi[i][3]}
  #define PIN(x) asm volatile("":"+v"(x))
  #define MX3(a,b,c) __builtin_fmaxf(__builtin_fmaxf((a),(b)),(c))
  #define GAPA(MF,A0,A1,A2,A3,W0,W1,PW) do{ MF; sacc+=A0; sacc+=A1; sacc+=A2; sacc+=A3; PIN(sacc); W0; W1; PIN(PW); SBAR(); }while(0)
  #define EX(v) __builtin_amdgcn_exp2f(v)
  #define GAPB(MF,X,B) do{ MF; X[B]=EX(X[B]); X[B+1]=EX(X[B+1]); X[B+2]=EX(X[B+2]); X[B+3]=EX(X[B+3]); PIN(X); SBAR(); }while(0)
  #define VRD(i) do{ vlo[i]=vtr(vp_+(((i)>>2)*4096+((i)&3)*1024)); vhi[i]=vtr(vp_+(((i)>>2)*4096+((i)&3)*1024+512)); }while(0)
  #define KRD(G,j) do{ if(G){ kload2(kf,kp0+sl_next,j); SBAR(); } }while(0)
  #define STEP(C0,C1,P0,P1,t,GK,GV,GL) do{ SBAR(); \
    const lds_cptr vp_=vp0+sl_prev; \
    VRD(0); SBAR(); float sacc=(P0[0]+P0[1]); \
    GAPA(C0=__builtin_amdgcn_mfma_f32_32x32x16_bf16(kf[0],qr[0],zero16,0,0,0), P0[2],P0[3],P0[4],P0[5],     pw0[0]=PKW(P0,0), pw0[1]=PKW(P0,2), pw0); \
    VRD(4); SBAR(); GAPA(C1=__builtin_amdgcn_mfma_f32_32x32x16_bf16(kf[1],qr[0],zero16,0,0,0), P0[6],P0[7],P0[8],P0[9],     pw0[2]=PKW(P0,4), pw0[3]=PKW(P0,6), pw0); \
    VRD(1); SBAR(); GAPA(C0=__builtin_amdgcn_mfma_f32_32x32x16_bf16(kf[2],qr[1],C0,0,0,0),   P0[10],P0[11],P0[12],P0[13], pw1[0]=PKW(P0,8), pw1[1]=PKW(P0,10), pw1); \
    VRD(5); SBAR(); GAPA(C1=__builtin_amdgcn_mfma_f32_32x32x16_bf16(kf[3],qr[1],C1,0,0,0),   P0[14],P0[15],P1[0],P1[1],   pw1[2]=PKW(P0,12),pw1[3]=PKW(P0,14), pw1); \
    VRD(2); SBAR(); GAPA(C0=__builtin_amdgcn_mfma_f32_32x32x16_bf16(kf[4],qr[2],C0,0,0,0),   P1[2],P1[3],P1[4],P1[5],     pw2[0]=PKW(P1,0), pw2[1]=PKW(P1,2), pw2); \
    VRD(6); SBAR(); GAPA(C1=__builtin_amdgcn_mfma_f32_32x32x16_bf16(kf[5],qr[2],C1,0,0,0),   P1[6],P1[7],P1[8],P1[9],     pw2[2]=PKW(P1,4), pw2[3]=PKW(P1,6), pw2); \
    VRD(3); SBAR(); GAPA(C0=__builtin_amdgcn_mfma_f32_32x32x16_bf16(kf[6],qr[3],C0,0,0,0),   P1[10],P1[11],P1[12],P1[13], pw3[0]=PKW(P1,8), pw3[1]=PKW(P1,10), pw3); \
    VRD(7); SBAR(); GAPA(C1=__builtin_amdgcn_mfma_f32_32x32x16_bf16(kf[7],qr[3],C1,0,0,0),   P1[14],P1[15],0.f,0.f,       pw3[2]=PKW(P1,12),pw3[3]=PKW(P1,14), pw3); \
    l_reg+=sacc; \
    if(GK){DMA_K((t)+3,sl_cur);} if(GV){DMA_V((t)+1,sl_next);} \
    kbias(C0,C1,bt,t,hi,mhat); \
    CMASK(C0,C1,t); \
    { float a=MX3(C0[0],C0[1],C1[0]),b=MX3(C0[2],C0[3],C1[1]); a=MX3(a,C1[2],C1[3]); \
      _Pragma("unroll") for(int r=4;r<16;r+=4){a=MX3(a,C0[r],C0[r+1]);b=MX3(b,C0[r+2],C0[r+3]);a=MX3(a,C1[r],C1[r+1]);b=MX3(b,C1[r+2],C1[r+3]);} \
      float rm=__builtin_fmaxf(a,b); { auto rr=__builtin_amdgcn_permlane32_swap(__float_as_uint(rm),__float_as_uint(rm),false,false); rm=__builtin_fmaxf(__uint_as_float(rr[0]),__uint_as_float(rr[1])); } \
      resc=false; \
      if(__builtin_expect(__any(rm>(float)THRL),0)){ const float dl=__builtin_fmaxf(rm,0.f); mhat+=dl; \
        _Pragma("unroll") for(int r=0;r<16;++r){C0[r]-=dl;C1[r]-=dl;} \
        const float f=__builtin_amdgcn_exp2f(-dl); l_reg*=f; if(hi==0)wsf[r32]=f; resc=true; } } \
    SBAR(); \
    GAPB(o[0]=__builtin_amdgcn_mfma_f32_32x32x16_bf16(PAF(0),VFR(0),o[0],0,0,0), C0,0); \
    GAPB(o[1]=__builtin_amdgcn_mfma_f32_32x32x16_bf16(PAF(0),VFR(4),o[1],0,0,0), C0,4); \
    KRD(GL,0); GAPB(o[0]=__builtin_amdgcn_mfma_f32_32x32x16_bf16(PAF(1),VFR(1),o[0],0,0,0), C0,8); \
    KRD(GL,1); GAPB(o[1]=__builtin_amdgcn_mfma_f32_32x32x16_bf16(PAF(1),VFR(5),o[1],0,0,0), C0,12); \
    KRD(GL,2); GAPB(o[0]=__builtin_amdgcn_mfma_f32_32x32x16_bf16(PAF(2),VFR(2),o[0],0,0,0), C1,0); \
    KRD(GL,3); GAPB(o[1]=__builtin_amdgcn_mfma_f32_32x32x16_bf16(PAF(2),VFR(6),o[1],0,0,0), C1,4); \
    GAPB(o[0]=__builtin_amdgcn_mfma_f32_32x32x16_bf16(PAF(3),VFR(3),o[0],0,0,0), C1,8); \
    GAPB(o[1]=__builtin_amdgcn_mfma_f32_32x32x16_bf16(PAF(3),VFR(7),o[1],0,0,0), C1,12); \
    }while(0)
  int t=1;
  #undef CMASK
  #define CMASK(P0,P1,t) do{}while(0)
  for(;t+5<NT;t+=2){
    STEP(pB0,pB1,pA0,pA1,t,true,true,true);     WAIT_BAR(2); RESC(); ROT();
    STEP(pA0,pA1,pB0,pB1,t+1,true,true,true);   WAIT_BAR(2); RESC(); ROT();
  }
  #undef CMASK
  #define CMASK(P0,P1,t) do{int jb_=(t)-(NT-4); if(jb_>=0)cmask(P0,P1,jb_,qrel,hi);}while(0)
  #define ENDW(tt) do{ if((tt)+3<NT){WAIT_BAR(2);} else if((tt)+2<NT){WAIT_BAR(1);} else {WAIT_BAR(0);} }while(0)
  for(;t+1<NT;t+=2){
    STEP(pB0,pB1,pA0,pA1,t,(t+3<NT),(t+1<NT),(t+1<NT));       ENDW(t);   RESC(); ROT();
    STEP(pA0,pA1,pB0,pB1,t+1,(t+4<NT),(t+2<NT),(t+2<NT));     ENDW(t+1); RESC(); ROT();
  }
  STEP(pB0,pB1,pA0,pA1,NT-1,false,false,false); RESC();
  { float sacc=pB0[0]+pB0[1]; _Pragma("unroll") for(int r=2;r<16;++r)sacc+=pB0[r]; _Pragma("unroll") for(int r=0;r<16;++r)sacc+=pB1[r]; l_reg+=sacc;
    pw0=(u32x4){PKW(pB0,0),PKW(pB0,2),PKW(pB0,4),PKW(pB0,6)};pw1=(u32x4){PKW(pB0,8),PKW(pB0,10),PKW(pB0,12),PKW(pB0,14)};pw2=(u32x4){PKW(pB1,0),PKW(pB1,2),PKW(pB1,4),PKW(pB1,6)};pw3=(u32x4){PKW(pB1,8),PKW(pB1,10),PKW(pB1,12),PKW(pB1,14)};
    SBAR(); pv(o,vb0+sl_cur,PAF(0),PAF(1),PAF(2),PAF(3)); }
  #undef PKW
  #undef PAF
  #undef VFR
  #undef PIN
  #undef MX3
  #undef GAPA
  #undef GAPB
  #undef EX
  #undef VRD
  #undef KRD
  #undef STEP
  #undef ENDW
  {auto rr=__builtin_amdgcn_permlane32_swap(__float_as_uint(l_reg),__float_as_uint(l_reg),false,false);l_reg=__uint_as_float(rr[0])+__uint_as_float(rr[1]);}
  if(hi==0)wsf[32+r32]=l_reg;asm volatile("s_waitcnt lgkmcnt(0)":::"memory");
  float rli[16];
  #pragma unroll
  for(int r=0;r<16;++r)rli[r]=__builtin_amdgcn_rcpf(wsf[32+crow(r,hi)]);
  bf16*Ow=O+(rowbase+q0+wid*QBLK)*DMA+h*D;
  { bf16*stg=(bf16*)(shm+LDS_OST)+wid*2048;
    #pragma unroll
    for(int r=0;r<16;++r){const int orow=crow(r,hi);
      #pragma unroll
      for(int d0=0;d0<2;++d0)stg[orow*64+d0*32+r32]=__float2bfloat16(o[d0][r]*rli[r]);}
    asm volatile("s_waitcnt lgkmcnt(0)":::"memory");
    #pragma unroll
    for(int i=0;i<4;++i){const int row=i*8+(lane>>3),ch=lane&7; const u32x4 v=*(const u32x4*)(stg+row*64+ch*8); ATTN_STORE16(Ow+(long)row*DMA+ch*8,v);} }
  asm volatile("s_waitcnt lgkmcnt(0)\n\ts_barrier":::"memory");
  #undef DMA_K
  #undef DMA_V
  #undef CMASK
  #undef START
  #undef RESC
  #undef ROT
}
#undef SBAR
#undef WAIT_BAR
}

constexpr size_t MiB = 1u << 20;
constexpr size_t WS_CTL = 0, CTL_ZERO_BYTES = 1 * MiB;
constexpr size_t WS_PART = 1 * MiB;
constexpr size_t WS_SKIN = 3 * MiB;
constexpr size_t WS_WSK  = 5 * MiB;
constexpr size_t WS_CUM  = 6 * MiB;
constexpr size_t WS_WIN = 8 * MiB, WS_WOUT = 20 * MiB, WS_WGU = 24 * MiB, WS_WDOWN = 68 * MiB, WS_WKVQ = 90 * MiB, WS_WQ3 = 96 * MiB, WS_WO = 98 * MiB;
constexpr size_t WS_HB = 104 * MiB;
constexpr size_t WS_BIG = 168 * MiB;
constexpr size_t WS_PROJ = WS_BIG;
constexpr size_t WS_OA = WS_BIG + 192 * MiB;
constexpr size_t WS_ACT_GLA = WS_BIG;
constexpr size_t WS_K = WS_BIG, WS_V = WS_BIG + 64 * MiB, WS_QO = WS_BIG + 128 * MiB;
constexpr size_t WS_ACT_FOX = WS_BIG + 128 * MiB;
constexpr size_t WS_END = WS_BIG + 128 * MiB + 176 * MiB;
static_assert(WS_END <= 512 * MiB, "workspace map");
constexpr int CW_BAR = 4096;

constexpr int NWAVES = 8;
constexpr int RING_OFF = 0, RING_BYTES = 131072;
constexpr int LDSCTL_OFF = RING_BYTES, MISC_OFF = LDSCTL_OFF + 320;
constexpr int LDS_BYTES = 147456;

#define GAS __attribute__((address_space(1)))
#define LAS __attribute__((address_space(3)))
typedef unsigned short bf16;
typedef unsigned v4u __attribute__((ext_vector_type(4)));
typedef unsigned v2u __attribute__((ext_vector_type(2)));
typedef float f32x4 __attribute__((ext_vector_type(4)));
typedef float f32x2 __attribute__((ext_vector_type(2)));
typedef short bf16x8 __attribute__((ext_vector_type(8)));
typedef GAS unsigned gu32;
#define RLX_AGENT __ATOMIC_RELAXED, __HIP_MEMORY_SCOPE_AGENT
#define LDS_WAIT() asm volatile("s_waitcnt lgkmcnt(0)" ::: "memory")
#define VM_WAIT() asm volatile("s_waitcnt vmcnt(0)" ::: "memory")
__device__ __forceinline__ unsigned f2bf(float f) { unsigned u = __builtin_bit_cast(unsigned, f); return (u + 0x7fffu + ((u >> 16) & 1u)) >> 16; }
__device__ __forceinline__ unsigned pk2(float lo, float hi) { return f2bf(lo) | (f2bf(hi) << 16); }
__device__ __forceinline__ float bf2f(unsigned short b) { return __builtin_bit_cast(float, (unsigned)b << 16); }
__device__ __forceinline__ float log_sigmoid_f(float x) { return fminf(x, 0.f) - log1pf(expf(-fabsf(x))); }

#define XB_TMO      128
#define XB_XCNT(j)  (256  + 64 * (j))
#define XB_XSUB(j)  (1280 + 64 * (j))
#define XB_XGEN(j)  (2304 + 64 * (j))
#define XB_TOP      3328
#define XB_TOPGEN   3392
#define XCD_BAR_WORDS 3456
#define XB_SPIN_CAP (1u << 18)
__device__ __forceinline__ unsigned xb_ld(unsigned* p)              { return __hip_atomic_load(p, __ATOMIC_RELAXED, __HIP_MEMORY_SCOPE_AGENT); }
__device__ __forceinline__ unsigned xb_add(unsigned* p, unsigned v) { return __hip_atomic_fetch_add(p, v, __ATOMIC_RELAXED, __HIP_MEMORY_SCOPE_AGENT); }
__device__ __forceinline__ unsigned xb_xcc_id() { return (unsigned)__builtin_amdgcn_s_getreg((3 << 11) | 20) & 0xFu; }
#define XB_SPIN(cond, bar) do { unsigned _sp = 0; while (cond) { __builtin_amdgcn_s_sleep(1); \
    if ((++_sp & 255u) == 0u) { if (xb_ld(&(bar)[XB_TMO])) break; if (_sp > XB_SPIN_CAP) { atomicAdd(&(bar)[XB_TMO], 1u); break; } } } } while (0)
struct XcdBarrier { unsigned* bar; unsigned x; volatile LAS unsigned* st; };
__device__ __forceinline__ XcdBarrier xcd_barrier_post(unsigned* bar, volatile LAS unsigned* st) {
    XcdBarrier b; b.bar = bar; b.x = xb_xcc_id(); b.st = st;
    if (threadIdx.x == 0) (void)xb_add(&bar[XB_XCNT(b.x)], 1u);
    return b;
}
__device__ __forceinline__ void xcd_barrier_complete(unsigned* bar, unsigned x, unsigned& nloc, unsigned& nx) {
    const unsigned G = gridDim.x * gridDim.y * gridDim.z;
    unsigned sum, cnt, mine, sp = 0u;
    for (;;) {
        sum = 0u; cnt = 0u; mine = 0u;
#pragma unroll
        for (unsigned j = 0; j < 16; ++j) { const unsigned c = xb_ld(&bar[XB_XCNT(j)]); sum += c; cnt += (c > 0u) ? 1u : 0u; mine = (j == x) ? c : mine; }
        if (sum == G) break;
        __builtin_amdgcn_s_sleep(1);
        if ((++sp & 255u) == 0u) { if (xb_ld(&bar[XB_TMO])) break; if (sp > XB_SPIN_CAP) { atomicAdd(&bar[XB_TMO], 1u); break; } }
    }
    nloc = mine > 0u ? mine : 1u; nx = cnt > 0u ? cnt : 1u;
}
__device__ __forceinline__ void xcd_barrier(const XcdBarrier& b) {
    asm volatile("s_waitcnt vmcnt(0)" ::: "memory");
    __syncthreads();
    if (threadIdx.x == 0) {
        unsigned* bar = b.bar;
        __builtin_amdgcn_s_waitcnt(0);
        unsigned nloc = b.st[0], nx = b.st[1];
        if (nloc == 0u) { xcd_barrier_complete(bar, b.x, nloc, nx); b.st[0] = nloc; b.st[1] = nx; }
        const unsigned old = xb_add(&bar[XB_XSUB(b.x)], 1u);
        const unsigned gen = old / nloc;
        if (old + 1u == (gen + 1u) * nloc) {
            __builtin_amdgcn_fence(__ATOMIC_RELEASE, "agent");
            asm volatile("s_waitcnt vmcnt(0)" ::: "memory");
            const unsigned og = xb_add(&bar[XB_TOP], 1u);
            const unsigned tg = og / nx;
            if (og + 1u == (tg + 1u) * nx) xb_add(&bar[XB_TOPGEN], 1u);
            else XB_SPIN(xb_ld(&bar[XB_TOPGEN]) == tg, bar);
            __builtin_amdgcn_fence(__ATOMIC_ACQUIRE, "agent");
            xb_add(&bar[XB_XGEN(b.x)], 1u);
            asm volatile("s_waitcnt vmcnt(0)" ::: "memory");
        } else {
            XB_SPIN(xb_ld(&bar[XB_XGEN(b.x)]) == gen, bar);
            __builtin_amdgcn_fence(__ATOMIC_ACQUIRE, "agent");
            asm volatile("s_waitcnt vmcnt(0)" ::: "memory");
        }
    }
    __syncthreads();
}

struct Frame {
    LAS unsigned char* lds;
    volatile LAS unsigned* MISC;
    gu32* ctl;
    int tid, lane, wave;
    int vcu, G;
};
__device__ __forceinline__ float wave_sum(float v) {
#pragma unroll
    for (int o = 1; o < 64; o <<= 1) v += __shfl_xor(v, o);
    return v;
}

__device__ __forceinline__ void p0_transpose_item(const float* W, int ldw, int c0, int ncols, int K, const float* gain, float scale, int scale_cols, bf16* WT, int mode, LAS float* scr, int item, int lane) {
    const int nblk = ncols / 32, kb = item / nblk, nb = item % nblk, k0 = 64 * kb, n0 = 32 * nb;
#pragma unroll 8
    for (int i = 0; i < 32; ++i) { const int kk = 2 * i + (lane >> 5); const float gk = gain ? gain[k0 + kk] : 1.0f; scr[kk * 33 + (lane & 31)] = W[(size_t)(k0 + kk) * ldw + c0 + n0 + (lane & 31)] * gk; }
    LDS_WAIT(); asm volatile("" ::: "memory");
    const float sc = (n0 < scale_cols) ? scale : 1.0f;
    const int c = lane & 7;
#pragma unroll
    for (int j = 0; j < 4; ++j) { const int n = (lane >> 3) + 8 * j; const LAS float* s = scr + (8 * c) * 33 + n;
        v4u o; o.x = pk2(s[0 * 33] * sc, s[1 * 33] * sc); o.y = pk2(s[2 * 33] * sc, s[3 * 33] * sc); o.z = pk2(s[4 * 33] * sc, s[5 * 33] * sc); o.w = pk2(s[6 * 33] * sc, s[7 * 33] * sc);
        const int nn = n0 + n; int row = nn;
        if (mode == 1) { row = (nn < DFF) ? (256 * (nn / 128) + (nn % 128)) : (256 * ((nn - DFF) / 128) + 128 + ((nn - DFF) % 128)); }
        *(GAS v4u*)(WT + (size_t)row * K + k0 + 8 * c) = o; }
    LDS_WAIT(); asm volatile("" ::: "memory");
}

struct Args { const float* in[16]; float* out; unsigned char* ws; int lo, hi; };

__device__ __forceinline__ void skinny_phase(const Frame& F, const bf16* hb, const bf16* Wt, const float* part, float* out) {
    int tid_ = threadIdx.x; asm volatile("" : "+v"(tid_)); const int lane_ = tid_ & 63, wave_ = __builtin_amdgcn_readfirstlane(tid_ >> 6);
    const int gw = F.vcu * NWAVES + wave_, NGW = F.G * NWAVES, fr = lane_ & 15, fq = lane_ >> 4;
    for (int tile = gw; tile < MTOK / 16; tile += NGW) {
        const int row0 = tile * 16;
        const bf16* ap = hb + (size_t)(row0 + fr) * DM + fq * 8; const bf16* bp = Wt + (size_t)fr * DM + fq * 8;
        f32x4 acc = (f32x4){0.f, 0.f, 0.f, 0.f};
#pragma unroll 8
        for (int ks = 0; ks < DM / 32; ++ks) { const bf16x8 a = *(const bf16x8*)(ap + 32 * ks), b = *(const bf16x8*)(bp + 32 * ks); acc = __builtin_amdgcn_mfma_f32_16x16x32_bf16(a, b, acc, 0, 0, 0); }
#pragma unroll
        for (int r = 0; r < 4; ++r) { const int row = row0 + 4 * fq + r; out[(size_t)row * 16 + fr] = acc[r] * pg8::rstd_row(part, row); }
    }
}

__device__ __forceinline__ void gate_phase(const Frame& F, bf16* oa, const bf16* proj, const float* ghead) {
    int tid_ = threadIdx.x; asm volatile("" : "+v"(tid_)); const int lane_ = tid_ & 63, wave_ = __builtin_amdgcn_readfirstlane(tid_ >> 6);
    const int gw = F.vcu * NWAVES + wave_, NGW = F.G * NWAVES;
    for (int m = gw; m < MTOK; m += NGW) {
#pragma unroll
        for (int j = 0; j < 2; ++j) {
            const int col = lane_ * 8 + 512 * j;
            const v4u ov = *(const GAS v4u*)(oa + (size_t)m * GV + col); const v4u rv = *(const GAS v4u*)(proj + (size_t)m * GPROJ + 2048 + col);
            float o[8], r[8];
#pragma unroll
            for (int i = 0; i < 4; ++i) { o[2 * i] = __builtin_bit_cast(float, ov[i] << 16); o[2 * i + 1] = __builtin_bit_cast(float, ov[i] & 0xffff0000u); r[2 * i] = __builtin_bit_cast(float, rv[i] << 16); r[2 * i + 1] = __builtin_bit_cast(float, rv[i] & 0xffff0000u); }
            float ss = 0.f;
#pragma unroll
            for (int i = 0; i < 8; ++i) ss += o[i] * o[i];
#pragma unroll
            for (int s = 1; s < 32; s <<= 1) ss += __shfl_xor(ss, s);
            const float rs = 1.0f / sqrtf(ss * (1.0f / 256.0f) + EPS);
            const f32x4 g0 = *(const GAS f32x4*)(ghead + (col & 255)), g1 = *(const GAS f32x4*)(ghead + (col & 255) + 4);
            float a[8];
#pragma unroll
            for (int i = 0; i < 8; ++i) { const float g = i < 4 ? g0[i] : g1[i - 4]; a[i] = o[i] * rs * g * pg8::silu_f(r[i]); }
            v4u w; w.x = pk2(a[0], a[1]); w.y = pk2(a[2], a[3]); w.z = pk2(a[4], a[5]); w.w = pk2(a[6], a[7]);
            *(GAS v4u*)(oa + (size_t)m * GV + col) = w;
        }
    }
}

__device__ __forceinline__ void final_phase(const Frame& F, float* out, const float* part, const float* g) {
    int tid_ = threadIdx.x; asm volatile("" : "+v"(tid_)); const int lane_ = tid_ & 63, wave_ = __builtin_amdgcn_readfirstlane(tid_ >> 6);
    const int gw = F.vcu * NWAVES + wave_, NGW = F.G * NWAVES;
    for (int m = gw; m < MTOK; m += NGW) {
        const float rs = pg8::rstd_row(part, m);
        GAS f32x4* xr = (GAS f32x4*)(out + (size_t)m * DM) + lane_;
#pragma unroll
        for (int j = 0; j < 4; ++j) { const f32x4 v = xr[64 * j]; const f32x4 gg = *((const GAS f32x4*)g + lane_ + 64 * j); xr[64 * j] = v * rs * gg; }
    }
}

namespace gla {
constexpr int QD_OFF = 0, KD_OFF = 17408, KE_OFF = 34816, VT_OFF = 53248, AM_OFF = 62464, ST_OFF = 71680, AL_OFF = 89088, SEG_OFF = 93184, DEC_OFF = 97280, LDS_END = 97792;
constexpr int SW = 272, SN = 144;
static_assert(LDS_END <= RING_BYTES, "scan LDS map");
}
__device__ __forceinline__ void scan_phase(const Frame& F, const bf16* proj, const float* alow, const float* Wup, const float* balpha, bf16* oa) {
    using namespace gla;
#define SCAN_SYNC() do { asm volatile("s_waitcnt lgkmcnt(0)" ::: "memory"); __builtin_amdgcn_s_barrier(); asm volatile("" ::: "memory"); } while (0)
    typedef LAS const bf16x8* lfrag;
    int tid_ = threadIdx.x; asm volatile("" : "+v"(tid_));
    const int tid = tid_, lane = tid & 63, wave = __builtin_amdgcn_readfirstlane(tid >> 6), fr = lane & 15, fq = lane >> 4;
    LAS unsigned char* L = F.lds + RING_OFF;
    for (int unit = F.vcu; unit < BATCH * GH * 4; unit += F.G) {
        const int bh = unit >> 2, sl = unit & 3, b = bh >> 2, h = bh & 3;
        const size_t row0 = (size_t)b * SEQ;
        const int d0 = 2 * lane;
        float wu0[16], wu1[16];
#pragma unroll
        for (int j = 0; j < 16; ++j) { const f32x2 w2 = *(const f32x2*)(Wup + j * GQK + h * GDK + d0); wu0[j] = w2.x; wu1[j] = w2.y; }
        const f32x2 ba2 = *(const f32x2*)(balpha + h * GDK + d0);
        f32x4 S[4];
#pragma unroll
        for (int i = 0; i < 4; ++i) S[i] = (f32x4){0.f, 0.f, 0.f, 0.f};
        for (int i = tid; i < (64 * SW) / 4; i += NWAVES * 64) ((LAS unsigned*)(L + ST_OFF))[i] = 0u;
        const bf16* qbase = proj + (row0 + 8 * wave) * GPROJ + h * GDK + d0;
        const bf16* vbase = proj + (row0 + 8 * wave) * GPROJ + 2 * GQK + h * GDV + 64 * sl + lane;
        const float* abase = alow + (row0 + (tid >> 2)) * 16 + 4 * (tid & 3);
        unsigned qreg[8], kreg[8], vreg[8]; f32x4 alreg = (f32x4){0.f, 0.f, 0.f, 0.f};
#define GLA_LOAD(n) do { _Pragma("unroll") for (int i = 0; i < 8; ++i) { const size_t ro = ((size_t)(n) * 64 + i) * GPROJ; qreg[i] = *(const unsigned*)(qbase + ro); kreg[i] = *(const unsigned*)(qbase + ro + GQK); vreg[i] = (unsigned)vbase[ro]; } \
        if (tid < 256) alreg = *(const f32x4*)(abase + (size_t)(n) * 64 * 16); } while (0)
        GLA_LOAD(0);
        if (tid < 256) *(LAS f32x4*)(L + AL_OFF + tid * 16) = alreg;
        SCAN_SYNC();
        for (int n = 0; n < SEQ / 64; ++n) {
            float loc0[8], loc1[8]; float run0 = 0.f, run1 = 0.f;
#pragma unroll
            for (int i = 0; i < 8; ++i) {
                const LAS f32x4* ap = (const LAS f32x4*)(L + AL_OFF + (8 * wave + i) * 64);
                float z0 = ba2.x, z1 = ba2.y;
#pragma unroll
                for (int j4 = 0; j4 < 4; ++j4) { const f32x4 a = ap[j4];
#pragma unroll
                    for (int e = 0; e < 4; ++e) { z0 += a[e] * wu0[4 * j4 + e]; z1 += a[e] * wu1[4 * j4 + e]; } }
                const float l0 = (fminf(z0, 0.f) - 0.6931471805599453f * __builtin_amdgcn_logf(1.0f + __builtin_amdgcn_exp2f(-fabsf(z0) * LOG2E))) * 0.0625f;
                const float l1 = (fminf(z1, 0.f) - 0.6931471805599453f * __builtin_amdgcn_logf(1.0f + __builtin_amdgcn_exp2f(-fabsf(z1) * LOG2E))) * 0.0625f;
                run0 += l0; run1 += l1; loc0[i] = run0; loc1[i] = run1;
            }
            *(LAS f32x2*)(L + SEG_OFF + (wave * 128 + d0) * 4) = (f32x2){run0, run1};
            SCAN_SYNC();
#pragma unroll
            for (int i = 0; i < 8; ++i) asm volatile("" : "+v"(qreg[i]), "+v"(kreg[i]), "+v"(vreg[i]));
            float off0 = 0.f, off1 = 0.f, tot0 = 0.f, tot1 = 0.f;
#pragma unroll
            for (int w = 0; w < 8; ++w) { const f32x2 t2 = *(const LAS f32x2*)(L + SEG_OFF + (w * 128 + d0) * 4); if (w < wave) { off0 += t2.x; off1 += t2.y; } tot0 += t2.x; tot1 += t2.y; }
            const float edl0 = __builtin_amdgcn_exp2f(tot0 * LOG2E), edl1 = __builtin_amdgcn_exp2f(tot1 * LOG2E);
            unsigned ke0[4], ke1[4];
#pragma unroll
            for (int i = 0; i < 8; i += 2) {
                float kev0[2], kev1[2];
#pragma unroll
                for (int u = 0; u < 2; ++u) {
                    const float b0 = (off0 + loc0[i + u]) * LOG2E, b1 = (off1 + loc1[i + u]) * LOG2E;
                    const float eb0 = __builtin_amdgcn_exp2f(b0), eb1 = __builtin_amdgcn_exp2f(b1), en0 = __builtin_amdgcn_exp2f(-b0), en1 = __builtin_amdgcn_exp2f(-b1);
                    const float q0 = __builtin_bit_cast(float, qreg[i + u] << 16), q1 = __builtin_bit_cast(float, qreg[i + u] & 0xffff0000u);
                    const float k0 = __builtin_bit_cast(float, kreg[i + u] << 16), k1 = __builtin_bit_cast(float, kreg[i + u] & 0xffff0000u);
                    const int c = 8 * wave + i + u;
                    *(LAS unsigned*)(L + QD_OFF + c * SW + 2 * d0) = pg8::cvt_pk_bf16(q0 * eb0, q1 * eb1);
                    *(LAS unsigned*)(L + KD_OFF + c * SW + 2 * d0) = pg8::cvt_pk_bf16(k0 * en0, k1 * en1);
                    kev0[u] = k0 * en0 * edl0; kev1[u] = k1 * en1 * edl1;
                }
                ke0[i >> 1] = pg8::cvt_pk_bf16(kev0[0], kev0[1]); ke1[i >> 1] = pg8::cvt_pk_bf16(kev1[0], kev1[1]);
            }
            *(LAS v4u*)(L + KE_OFF + d0 * SN + 16 * wave) = (v4u){ke0[0], ke0[1], ke0[2], ke0[3]};
            *(LAS v4u*)(L + KE_OFF + (d0 + 1) * SN + 16 * wave) = (v4u){ke1[0], ke1[1], ke1[2], ke1[3]};
            if (wave == 0) *(LAS f32x2*)(L + DEC_OFF + d0 * 4) = (f32x2){edl0, edl1};
            { v4u vv; vv.x = vreg[0] | (vreg[1] << 16); vv.y = vreg[2] | (vreg[3] << 16); vv.z = vreg[4] | (vreg[5] << 16); vv.w = vreg[6] | (vreg[7] << 16);
              *(LAS v4u*)(L + VT_OFF + lane * SN + 16 * wave) = vv; }
            if (n + 1 < SEQ / 64) GLA_LOAD(n + 1);
            SCAN_SYNC();
            {
                const int ci = wave >> 1, sh = wave & 1;
#pragma unroll
                for (int tt = 0; tt < 2; ++tt) {
                    const int si = 2 * sh + tt; f32x4 acc = (f32x4){0.f, 0.f, 0.f, 0.f};
                    if (si <= ci) {
#pragma unroll
                        for (int ks = 0; ks < 4; ++ks) { const bf16x8 a = *(lfrag)(L + QD_OFF + (16 * ci + fr) * SW + (32 * ks + 8 * fq) * 2), bb = *(lfrag)(L + KD_OFF + (16 * si + fr) * SW + (32 * ks + 8 * fq) * 2);
                            acc = __builtin_amdgcn_mfma_f32_16x16x32_bf16(a, bb, acc, 0, 0, 0); }
                    }
#pragma unroll
                    for (int r = 0; r < 4; ++r) { const int c = 16 * ci + 4 * fq + r, sx = 16 * si + fr; const float v = (sx <= c) ? acc[r] : 0.f;
                        *(LAS unsigned short*)(L + AM_OFF + c * SN + 2 * sx) = (unsigned short)f2bf(v); }
                }
            }
            {
                const f32x4 dec = *(const LAS f32x4*)(L + DEC_OFF + (16 * wave + 4 * fq) * 4);
#pragma unroll
                for (int vi = 0; vi < 4; ++vi) S[vi] = S[vi] * dec;
#pragma unroll
                for (int ks = 0; ks < 2; ++ks) { const bf16x8 a = *(lfrag)(L + KE_OFF + (16 * wave + fr) * SN + (32 * ks + 8 * fq) * 2);
#pragma unroll
                    for (int vi = 0; vi < 4; ++vi) { const bf16x8 bb = *(lfrag)(L + VT_OFF + (16 * vi + fr) * SN + (32 * ks + 8 * fq) * 2); S[vi] = __builtin_amdgcn_mfma_f32_16x16x32_bf16(a, bb, S[vi], 0, 0, 0); } }
            }
            SCAN_SYNC();
            {
                const int ci = wave >> 1, vh = wave & 1; f32x4 o0 = (f32x4){0.f, 0.f, 0.f, 0.f}, o1 = o0;
#pragma unroll
                for (int ks = 0; ks < 2; ++ks) { if (ks == 1 && ci < 2) continue;
                    const bf16x8 a = *(lfrag)(L + AM_OFF + (16 * ci + fr) * SN + (32 * ks + 8 * fq) * 2);
                    const bf16x8 b0 = *(lfrag)(L + VT_OFF + (32 * vh + fr) * SN + (32 * ks + 8 * fq) * 2), b1 = *(lfrag)(L + VT_OFF + (32 * vh + 16 + fr) * SN + (32 * ks + 8 * fq) * 2);
                    o0 = __builtin_amdgcn_mfma_f32_16x16x32_bf16(a, b0, o0, 0, 0, 0); o1 = __builtin_amdgcn_mfma_f32_16x16x32_bf16(a, b1, o1, 0, 0, 0); }
#pragma unroll
                for (int ks = 0; ks < 4; ++ks) {
                    const bf16x8 a = *(lfrag)(L + QD_OFF + (16 * ci + fr) * SW + (32 * ks + 8 * fq) * 2);
                    const bf16x8 b0 = *(lfrag)(L + ST_OFF + (32 * vh + fr) * SW + (32 * ks + 8 * fq) * 2), b1 = *(lfrag)(L + ST_OFF + (32 * vh + 16 + fr) * SW + (32 * ks + 8 * fq) * 2);
                    o0 = __builtin_amdgcn_mfma_f32_16x16x32_bf16(a, b0, o0, 0, 0, 0); o1 = __builtin_amdgcn_mfma_f32_16x16x32_bf16(a, b1, o1, 0, 0, 0); }
                bf16* op = oa + (row0 + (size_t)n * 64 + 16 * ci + 4 * fq) * GV + h * GDV + 64 * sl + 32 * vh + fr;
#pragma unroll
                for (int r = 0; r < 4; ++r) { op[(size_t)r * GV] = (bf16)f2bf(o0[r]); op[(size_t)r * GV + 16] = (bf16)f2bf(o1[r]); }
            }
            if (tid < 256 && n + 1 < SEQ / 64) *(LAS f32x4*)(L + AL_OFF + tid * 16) = alreg;
            SCAN_SYNC();
#pragma unroll
            for (int vi = 0; vi < 4; ++vi) { v2u w; w.x = pg8::cvt_pk_bf16(S[vi][0], S[vi][1]); w.y = pg8::cvt_pk_bf16(S[vi][2], S[vi][3]);
                *(LAS v2u*)(L + ST_OFF + (16 * vi + fr) * SW + (16 * wave + 4 * fq) * 2) = w; }
        }
#undef GLA_LOAD
        SCAN_SYNC();
    }
#undef SCAN_SYNC
}

__device__ __forceinline__ void attn_phase(const Frame& F, unsigned char* lds_generic, const float* flog, const float* b_f, const bf16* Q, const bf16* K, const bf16* V, bf16* O) {
    for (int bh = F.vcu; bh < BATCH * FH; bh += F.G) {
        const int b = bh / FH, h = bh % FH;
        LAS float* bt = (LAS float*)(F.lds + RING_OFF + attn_body::LDS_BIAS); LAS float* wt = (LAS float*)(F.lds + RING_OFF + attn_body::LDS_SCAN);
        const float bf = b_f[h];
        float ls[4]; float run = 0.f;
#pragma unroll
        for (int i = 0; i < 4; ++i) { const float x = flog[((size_t)b * SEQ + 4 * F.tid + i) * 16 + h] + bf; run += log_sigmoid_f(x); ls[i] = run; }
        float incl = run;
#pragma unroll
        for (int o = 1; o < 64; o <<= 1) { const float y = __shfl_up(incl, o); if (F.lane >= o) incl += y; }
        if (F.lane == 63) wt[F.wave] = incl;
        LDS_WAIT(); __syncthreads();
        float off = 0.f;
        for (int w = 0; w < F.wave; ++w) off += wt[w];
        const float excl = off + incl - run;
#pragma unroll
        for (int i = 0; i < 4; ++i) bt[4 * F.tid + i] = -(excl + ls[i]) * LOG2E;
        LDS_WAIT(); __syncthreads();
        for (int i = 0; i < attn_body::NQB; ++i)
            attn_body::attn_unit<8>(b, h, attn_body::NQB - 1 - i, (const attn_body::bf16*)Q, (const attn_body::bf16*)K, (const attn_body::bf16*)V, (attn_body::bf16*)O, (char*)lds_generic + RING_OFF);
        __syncthreads();
    }
}

__global__ void __launch_bounds__(NWAVES * 64, 2) yoco_fwd(Args args) {
    extern __shared__ __attribute__((aligned(16))) unsigned char lds[];
    Frame F;
    F.lds = (LAS unsigned char*)lds;
    F.MISC = (volatile LAS unsigned*)(F.lds + MISC_OFF);
    F.tid = threadIdx.x; F.lane = F.tid & 63; F.wave = __builtin_amdgcn_readfirstlane(F.tid >> 6);
    F.G = gridDim.x; { const int bx = blockIdx.x; F.vcu = (F.G % 8 == 0) ? (bx % 8) * (F.G / 8) + bx / 8 : bx; }
    unsigned char* ws = args.ws;
    F.ctl = (gu32*)(ws + WS_CTL);
    const int lo = args.lo, hi = args.hi;
    for (int u = F.tid; u < (LDS_BYTES - LDSCTL_OFF) / 4; u += NWAVES * 64) ((LAS unsigned*)(F.lds + LDSCTL_OFF))[u] = 0u;
    __syncthreads();
    XcdBarrier bar; bar.bar = (unsigned*)(F.ctl + CW_BAR); bar.x = 0; bar.st = nullptr;
    if (hi - lo > 1) bar = xcd_barrier_post((unsigned*)(F.ctl + CW_BAR), F.MISC + 8);
#define ON(s) (lo <= (s) && (s) < hi)
#define SEAM(s) do { if (lo <= (s) && (s) + 1 < hi) xcd_barrier(bar); } while (0)

    const float* x = args.in[0]; const float* attn_norm = args.in[1]; const float* ffn_norm = args.in[2]; const float* gla_w_in = args.in[3];
    const float* gla_g_head = args.in[6]; const float* gla_w_out = args.in[7];
    const float* kv_norm = args.in[8]; const float* w_kv = args.in[9]; const float* b_f = args.in[10]; const float* fox_w_q = args.in[11]; const float* fox_w_o = args.in[12];
    const float* ffn_w_gu = args.in[13]; const float* ffn_w_down = args.in[14]; const float* final_norm = args.in[15];
    float* out = args.out;
    float* part = (float*)(ws + WS_PART); float* skin = (float*)(ws + WS_SKIN); bf16* wsk = (bf16*)(ws + WS_WSK);
    bf16* Win_t = (bf16*)(ws + WS_WIN); bf16* Wout_t = (bf16*)(ws + WS_WOUT); bf16* Wgu_t = (bf16*)(ws + WS_WGU); bf16* Wdown_t = (bf16*)(ws + WS_WDOWN);
    bf16* Wkvq_t = (bf16*)(ws + WS_WKVQ); bf16* Wq3_t = (bf16*)(ws + WS_WQ3); bf16* Wo_t = (bf16*)(ws + WS_WO);
    bf16* hb = (bf16*)(ws + WS_HB); bf16* proj = (bf16*)(ws + WS_PROJ); bf16* oa = (bf16*)(ws + WS_OA);
    bf16* Kb = (bf16*)(ws + WS_K); bf16* Vb = (bf16*)(ws + WS_V); bf16* QO = (bf16*)(ws + WS_QO);

    if (ON(0)) {
        LAS float* scr = (LAS float*)(F.lds + RING_OFF + F.wave * 16384);
        const int gw = F.vcu * NWAVES + F.wave, NGW = F.G * NWAVES;
        constexpr int I_IN = (DM / 64) * (GPROJ / 32), I_SQ = (DM / 64) * (DM / 32), I_GU = (DM / 64) * (NGU / 32), I_DN = (DFF / 64) * (DM / 32), I_KV = (DM / 64) * (2048 / 32);
        constexpr int NITEMS = 2 * I_IN + 2 * I_SQ + 4 * I_GU + 4 * I_DN + I_KV + 2 * I_SQ + 2 * I_SQ;
        for (int it = gw; it < NITEMS; it += NGW) {
            int r = it;
            if (r < 2 * I_IN) { const int l = r / I_IN; r -= l * I_IN; p0_transpose_item(gla_w_in + (size_t)l * DM * GIN, GIN, 0, GPROJ, DM, attn_norm + l * DM, QSCALE_GLA, GQK, Win_t + (size_t)l * GPROJ * DM, 0, scr, r, F.lane); continue; } r -= 2 * I_IN;
            if (r < 2 * I_SQ) { const int l = r / I_SQ; r -= l * I_SQ; p0_transpose_item(gla_w_out + (size_t)l * DM * DM, DM, 0, DM, DM, nullptr, 1.f, 0, Wout_t + (size_t)l * DM * DM, 0, scr, r, F.lane); continue; } r -= 2 * I_SQ;
            if (r < 4 * I_GU) { const int l = r / I_GU; r -= l * I_GU; p0_transpose_item(ffn_w_gu + (size_t)l * DM * NGU, NGU, 0, NGU, DM, ffn_norm + l * DM, 1.f, 0, Wgu_t + (size_t)l * NGU * DM, 1, scr, r, F.lane); continue; } r -= 4 * I_GU;
            if (r < 4 * I_DN) { const int l = r / I_DN; r -= l * I_DN; p0_transpose_item(ffn_w_down + (size_t)l * DFF * DM, DM, 0, DM, DFF, nullptr, 1.f, 0, Wdown_t + (size_t)l * DM * DFF, 0, scr, r, F.lane); continue; } r -= 4 * I_DN;
            if (r < I_KV) { p0_transpose_item(w_kv, KVOUT, 0, 2048, DM, kv_norm, 1.f, 0, Wkvq_t, 0, scr, r, F.lane); continue; } r -= I_KV;
            if (r < 2 * I_SQ) { const int l = r / I_SQ; r -= l * I_SQ; p0_transpose_item(fox_w_q + (size_t)l * DM * DM, DM, 0, DM, DM, attn_norm + (2 + l) * DM, QSCALE_FOX, DM, l == 0 ? Wkvq_t + (size_t)2048 * DM : Wq3_t, 0, scr, r, F.lane); continue; } r -= 2 * I_SQ;
            { const int l = r / I_SQ; r -= l * I_SQ; p0_transpose_item(fox_w_o + (size_t)l * DM * DM, DM, 0, DM, DM, nullptr, 1.f, 0, Wo_t + (size_t)l * DM * DM, 0, scr, r, F.lane); }
        }
        for (int e = (F.vcu * NWAVES * 64 + F.tid); e < 3 * 16 * DM; e += F.G * NWAVES * 64) {
            const int j = e / (16 * DM), n = (e / DM) % 16, k = e % DM; float v;
            if (j < 2) v = gla_w_in[(size_t)j * DM * GIN + (size_t)k * GIN + GPROJ + n] * attn_norm[j * DM + k]; else v = w_kv[(size_t)k * KVOUT + 2048 + n] * kv_norm[k];
            wsk[e] = (bf16)f2bf(v);
        }
        for (int m = gw; m < MTOK; m += NGW) {
            const GAS f32x4* xr = (const GAS f32x4*)(x + (size_t)m * DM) + F.lane; f32x4 v[4]; float s = 0.f;
#pragma unroll
            for (int j = 0; j < 4; ++j) { v[j] = xr[64 * j]; s += (v[j][0] * v[j][0] + v[j][1] * v[j][1]) + (v[j][2] * v[j][2] + v[j][3] * v[j][3]); }
            s = wave_sum(s);
            GAS v2u* o8 = (GAS v2u*)(hb + (size_t)m * DM) + F.lane;
#pragma unroll
            for (int j = 0; j < 4; ++j) { v2u w; w.x = pk2(v[j][0], v[j][1]); w.y = pk2(v[j][2], v[j][3]); o8[64 * j] = w; }
            if (F.lane < 16) part[(size_t)m * 16 + F.lane] = (F.lane == 0) ? s : 0.f;
        }
    }
    SEAM(0);

    for (int l = 0; l < 2; ++l) {
        const int sb = 1 + 6 * l;
        const float* hin = (l == 0) ? x : out;
        if (ON(sb)) {
            skinny_phase(F, hb, wsk + (size_t)l * 16 * DM, part, skin);
            pg8::Gemm g{hb, Win_t + (size_t)l * GPROJ * DM, MTOK, GPROJ, DM}; pg8::StaticOrder S; S.init(MTOK, GPROJ, F.G, (int)blockIdx.x);
            pg8::EpiRowScaleBf16 E{proj, GPROJ, part, 0, 0};
            pg8::gemm_phase<pg8::EpiRowScaleBf16, pg8::StaticOrder, true, true>(F.lds + RING_OFF, g, S, E);
        }
        SEAM(sb);
        if (ON(sb + 1)) {
#if !NAIVE_SCAN
            scan_phase(F, proj, skin, args.in[4] + (size_t)l * GRANK * GQK, args.in[5] + (size_t)l * GQK, oa);
#endif
        }
        SEAM(sb + 1);
        if (ON(sb + 2)) gate_phase(F, oa, proj, gla_g_head + l * GDV);
        SEAM(sb + 2);
        if (ON(sb + 3)) {
            pg8::Gemm g{oa, Wout_t + (size_t)l * DM * DM, MTOK, DM, DM}; pg8::StaticOrder S; S.init(MTOK, DM, F.G, (int)blockIdx.x);
            pg8::EpiResid E{hin, out, hb, part};
            pg8::gemm_phase<pg8::EpiResid, pg8::StaticOrder, true, true>(F.lds + RING_OFF, g, S, E);
        }
        SEAM(sb + 3);
        bf16* act = (bf16*)(ws + WS_ACT_GLA);
        if (ON(sb + 4)) {
            pg8::Gemm g{hb, Wgu_t + (size_t)l * NGU * DM, MTOK, NGU, DM}; pg8::StaticOrder S; S.init(MTOK, NGU, F.G, (int)blockIdx.x);
            pg8::EpiSwiglu E{act, DFF, part};
            pg8::gemm_phase<pg8::EpiSwiglu, pg8::StaticOrder, true, true>(F.lds + RING_OFF, g, S, E);
        }
        SEAM(sb + 4);
        if (ON(sb + 5)) {
            pg8::Gemm g{act, Wdown_t + (size_t)l * DM * DFF, MTOK, DM, DFF}; pg8::StaticOrder S; S.init(MTOK, DM, F.G, (int)blockIdx.x);
            pg8::EpiResid E{out, out, hb, part};
            pg8::gemm_phase<pg8::EpiResid, pg8::StaticOrder, true, true>(F.lds + RING_OFF, g, S, E);
        }
        SEAM(sb + 5);
    }

    for (int j = 0; j < 2; ++j) {
        const int sb = 13 + 5 * j;
        if (ON(sb)) {
            if (j == 0) {
                skinny_phase(F, hb, wsk + (size_t)2 * 16 * DM, part, skin);
                pg8::Gemm g{hb, Wkvq_t, MTOK, 3 * DM, DM}; pg8::StaticOrder S; S.init(MTOK, 3 * DM, F.G, (int)blockIdx.x);
                pg8::EpiRowScaleBf16 E{Kb, DM, part, DM, (size_t)MTOK * DM};
                pg8::gemm_phase<pg8::EpiRowScaleBf16, pg8::StaticOrder, true, true>(F.lds + RING_OFF, g, S, E);
            } else {
                pg8::Gemm g{hb, Wq3_t, MTOK, DM, DM}; pg8::StaticOrder S; S.init(MTOK, DM, F.G, (int)blockIdx.x);
                pg8::EpiRowScaleBf16 E{QO, DM, part, 0, 0};
                pg8::gemm_phase<pg8::EpiRowScaleBf16, pg8::StaticOrder, true, true>(F.lds + RING_OFF, g, S, E);
            }
        }
        SEAM(sb);
        if (ON(sb + 1)) {
#if !NAIVE_ATTN
            attn_phase(F, lds, skin, b_f, QO, Kb, Vb, QO);
#endif
        }
        SEAM(sb + 1);
        if (ON(sb + 2)) {
            pg8::Gemm g{QO, Wo_t + (size_t)j * DM * DM, MTOK, DM, DM}; pg8::StaticOrder S; S.init(MTOK, DM, F.G, (int)blockIdx.x);
            pg8::EpiResid E{out, out, hb, part};
            pg8::gemm_phase<pg8::EpiResid, pg8::StaticOrder, true, true>(F.lds + RING_OFF, g, S, E);
        }
        SEAM(sb + 2);
        bf16* act = (bf16*)(ws + WS_ACT_FOX);
        if (ON(sb + 3)) {
            pg8::Gemm g{hb, Wgu_t + (size_t)(2 + j) * NGU * DM, MTOK, NGU, DM}; pg8::StaticOrder S; S.init(MTOK, NGU, F.G, (int)blockIdx.x);
            pg8::EpiSwiglu E{act, DFF, part};
            pg8::gemm_phase<pg8::EpiSwiglu, pg8::StaticOrder, true, true>(F.lds + RING_OFF, g, S, E);
        }
        SEAM(sb + 3);
        if (ON(sb + 4)) {
            pg8::Gemm g{act, Wdown_t + (size_t)(2 + j) * DM * DFF, MTOK, DM, DFF}; pg8::StaticOrder S; S.init(MTOK, DM, F.G, (int)blockIdx.x);
            pg8::EpiResid E{out, out, hb, part};
            pg8::gemm_phase<pg8::EpiResid, pg8::StaticOrder, true, true>(F.lds + RING_OFF, g, S, E);
        }
        SEAM(sb + 4);
    }
    if (ON(23)) final_phase(F, out, part, final_norm);
#undef ON
#undef SEAM
}

__global__ void __launch_bounds__(256) naive_gla(const bf16* proj, const float* alow, const float* Wup, const float* balpha, bf16* o) {
    const int bh = blockIdx.x, b = bh / GH, h = bh % GH, tid = threadIdx.x;
    __shared__ float sq[128], sk[128], sal[128];
    float S[128];
#pragma unroll
    for (int d = 0; d < 128; ++d) S[d] = 0.f;
    float wup[16], bal = 0.f;
#pragma unroll
    for (int j = 0; j < 16; ++j) wup[j] = (tid < 128) ? Wup[j * GQK + h * GDK + tid] : 0.f;
    if (tid < 128) bal = balpha[h * GDK + tid];
    for (int t = 0; t < SEQ; ++t) {
        const size_t row = (size_t)b * SEQ + t;
        if (tid < 128) {
            float z = bal;
#pragma unroll
            for (int j = 0; j < 16; ++j) z += alow[row * 16 + j] * wup[j];
            sal[tid] = expf(log_sigmoid_f(z) * (1.0f / 16.0f));
            sq[tid] = bf2f(proj[row * GPROJ + h * GDK + tid]); sk[tid] = bf2f(proj[row * GPROJ + GQK + h * GDK + tid]);
        }
        __syncthreads();
        const float v = bf2f(proj[row * GPROJ + 2 * GQK + h * GDV + tid]);
        float acc = 0.f;
#pragma unroll
        for (int d = 0; d < 128; ++d) { S[d] = sal[d] * S[d] + sk[d] * v; acc += sq[d] * S[d]; }
        o[row * GV + h * GDV + tid] = (bf16)f2bf(acc);
        __syncthreads();
    }
}
__global__ void naive_cum(const float* flog, const float* b_f, float* c) {
    const int bh = blockIdx.x * blockDim.x + threadIdx.x; if (bh >= BATCH * FH) return;
    const int b = bh / FH, h = bh % FH; float run = 0.f;
    for (int t = 0; t < SEQ; ++t) { run += log_sigmoid_f(flog[((size_t)b * SEQ + t) * 16 + h] + b_f[h]); c[(size_t)bh * SEQ + t] = run; }
}
__global__ void __launch_bounds__(256) naive_attn(const bf16* Q, const bf16* K, const bf16* V, const float* c, bf16* O) {
    const int bh = blockIdx.y, b = bh / FH, h = bh % FH, t = blockIdx.x * 256 + threadIdx.x;
    float q[64], acc[64];
    const bf16* qp = Q + ((size_t)b * SEQ + t) * DM + h * FHD;
#pragma unroll
    for (int d = 0; d < 64; ++d) { q[d] = bf2f(qp[d]); acc[d] = 0.f; }
    const float* cb = c + (size_t)bh * SEQ; const float ct = cb[t];
    float m = -INFINITY, l = 0.f;
    for (int s = 0; s <= t; ++s) {
        const bf16* kp = K + ((size_t)b * SEQ + s) * DM + h * FHD; const bf16* vp = V + ((size_t)b * SEQ + s) * DM + h * FHD;
        float dot = 0.f;
#pragma unroll
        for (int d = 0; d < 64; ++d) dot += q[d] * bf2f(kp[d]);
        const float lg = dot + (ct - cb[s]) * LOG2E;
        const float mn = fmaxf(m, lg), al = exp2f(m - mn), p = exp2f(lg - mn);
        l = l * al + p;
#pragma unroll
        for (int d = 0; d < 64; ++d) acc[d] = acc[d] * al + p * bf2f(vp[d]);
        m = mn;
    }
    bf16* op = O + ((size_t)b * SEQ + t) * DM + h * FHD; const float rl = 1.0f / l;
#pragma unroll
    for (int d = 0; d < 64; ++d) op[d] = (bf16)f2bf(acc[d] * rl);
}

extern "C" void kernel_launch(void* const* d_in, const int* in_sizes, int n_in, void* d_out, int out_size, void* d_ws, size_t ws_size, hipStream_t stream) {
    static int grid = 0;
    if (grid == 0) {
        if (n_in != 16 || out_size != MTOK * DM || ws_size < WS_END) { fprintf(stderr, "kernel_launch: unexpected shapes (n_in %d, out %d, ws %zu)\n", n_in, out_size, ws_size); grid = -1; return; }
        int dev = 0, cus = 0, per_cu = 0;
        if (hipGetDevice(&dev) != hipSuccess || hipDeviceGetAttribute(&cus, hipDeviceAttributeMultiprocessorCount, dev) != hipSuccess) { grid = -1; return; }
        if (hipFuncSetAttribute((const void*)yoco_fwd, hipFuncAttributeMaxDynamicSharedMemorySize, LDS_BYTES) != hipSuccess) { fprintf(stderr, "kernel_launch: hipFuncSetAttribute failed\n"); grid = -1; return; }
        if (hipOccupancyMaxActiveBlocksPerMultiprocessor(&per_cu, (const void*)yoco_fwd, NWAVES * 64, LDS_BYTES) != hipSuccess || per_cu < 1) fprintf(stderr, "kernel_launch: occupancy query reports %d\n", per_cu);
        (void)hipGetLastError();
        grid = cus;
    }
    if (grid < 0) return;
    (void)hipMemsetAsync((char*)d_ws + WS_CTL, 0, CTL_ZERO_BYTES, stream);
    Args a{};
    for (int i = 0; i < 16; ++i) a.in[i] = (const float*)d_in[i];
    a.out = (float*)d_out; a.ws = (unsigned char*)d_ws;
    unsigned char* ws = (unsigned char*)d_ws;
#if KMODE == 1
    a.lo = 0; a.hi = 24;
    hipLaunchKernelGGL(yoco_fwd, dim3(grid), dim3(NWAVES * 64), LDS_BYTES, stream, a);
#else
    for (int s = 0; s < 24; ++s) {
        const bool is_scan = (s == 2 || s == 8), is_attn = (s == 14 || s == 19);
        if (is_scan && NAIVE_SCAN) {
            const int l = (s == 2) ? 0 : 1;
            hipLaunchKernelGGL(naive_gla, dim3(BATCH * GH), dim3(256), 0, stream, (const bf16*)(ws + WS_PROJ), (const float*)(ws + WS_SKIN),
                               (const float*)d_in[4] + (size_t)l * GRANK * GQK, (const float*)d_in[5] + (size_t)l * GQK, (bf16*)(ws + WS_OA));
            continue;
        }
        if (is_attn && NAIVE_ATTN) {
            hipLaunchKernelGGL(naive_cum, dim3(1), dim3(256), 0, stream, (const float*)(ws + WS_SKIN), (const float*)d_in[10], (float*)(ws + WS_CUM));
            hipLaunchKernelGGL(naive_attn, dim3(SEQ / 256, BATCH * FH), dim3(256), 0, stream, (const bf16*)(ws + WS_QO), (const bf16*)(ws + WS_K), (const bf16*)(ws + WS_V), (const float*)(ws + WS_CUM), (bf16*)(ws + WS_QO));
            continue;
        }
        a.lo = s; a.hi = s + 1;
        hipLaunchKernelGGL(yoco_fwd, dim3(grid), dim3(NWAVES * 64), LDS_BYTES, stream, a);
    }
#endif
}
```

```cpp
#include <hip/hip_runtime.h>
#include <hip/hip_bf16.h>
#include <cstdio>
#include <cstdint>
#include <cmath>

#ifndef KMODE
#define KMODE 1
#endif

#ifndef PROBE_STEP
#define PROBE_STEP (-1)
#endif
constexpr int BATCH = 16, SEQ = 2048, DM = 1024, MTOK = BATCH * SEQ;
constexpr int GH = 4, GDK = 128, GDV = 256, GQK = 512, GV = 1024, GRANK = 16, GIN = 3088, GPROJ = 3072;
constexpr int FH = 16, FHD = 64, KVOUT = 2064;
constexpr int DFF = 2816, NGU = 2 * DFF;
constexpr float EPS = 1e-6f;
constexpr float LOG2E = 1.4426950408889634f;
constexpr float QSCALE_GLA = 0.08838834764831845f;
constexpr float QSCALE_FOX = 0.125f * LOG2E;

namespace pg8 {
#define PG8_LAS __attribute__((address_space(3)))
typedef unsigned short bf16_t;
typedef short bf16x8 __attribute__((ext_vector_type(8)));
typedef float f32x4 __attribute__((ext_vector_type(4)));
typedef unsigned u32x4 __attribute__((ext_vector_type(4)));
typedef unsigned u32x2 __attribute__((ext_vector_type(2)));
constexpr int BM = 256, BK = 64, HALF = 128, HTB = HALF * BK * 2, STAGE_BYTES = 8 * HTB, NXCD = 8, WGM = 8;

__host__ __device__ __forceinline__ int lds_byte(int r, int c) { const int st = (r >> 4) * 2 + (c >> 5), rr = r & 15, cc = c & 31, ob = rr * 64 + cc * 2; return st * 1024 + (ob ^ (((ob >> 9) & 1) << 5)); }
__host__ __device__ __forceinline__ void stage_rc(int b, int& R, int& C) { const int st = b / 1024, sb = b % 1024, swz = sb ^ (((sb >> 9) & 1) << 5); R = (st >> 1) * 16 + swz / 64; C = (st & 1) * 32 + (swz % 64) / 2; }
__host__ __device__ __forceinline__ int perm32(int rho) { const int n = rho >> 4, i = rho & 15; return 8 * (i >> 2) + 4 * n + (i & 3); }

struct Unit { int pm, pn; };
struct Gemm { const bf16_t* A; const bf16_t* Bt; int M, N, K; };

struct StaticOrder {
    int nM, nN, nwg, G, c;
    __host__ __device__ void init(int M, int N, int G_, int c_) { nM = M / BM; nN = N / BM; nwg = nM * nN; G = G_; c = c_; }
    __host__ __device__ bool next(int i, Unit& u) const {
        const long L = (long)i * G + c; if (L >= nwg) return false;
        int wgid = (int)L; { const int q = nwg / NXCD, r = nwg % NXCD, xcd = wgid % NXCD, off = wgid / NXCD; wgid = (xcd < r ? xcd * (q + 1) : r * (q + 1) + (xcd - r) * q) + off; }
        const int nig = WGM * nN, gid = wgid / nig, fm = gid * WGM, gsz = (nM - fm) < WGM ? (nM - fm) : WGM;
        u.pm = fm + ((wgid % nig) % gsz); u.pn = (wgid % nig) / gsz; return true;
    }
    __device__ __forceinline__ void a_ready(const Unit&) const {}
    __device__ __forceinline__ void done(const Unit&) const {}
};

__device__ __forceinline__ unsigned cvt_pk_bf16(float lo, float hi) { unsigned r; asm volatile("v_cvt_pk_bf16_f32 %0, %1, %2" : "=v"(r) : "v"(lo), "v"(hi)); return r; }

__device__ __forceinline__ float rstd_row(const float* part, int row) {
    const f32x4* p = (const f32x4*)(part + (size_t)row * 16);
    const f32x4 a = p[0], b = p[1], c = p[2], d = p[3];
    const float s = (((a[0] + a[1]) + (a[2] + a[3])) + ((b[0] + b[1]) + (b[2] + b[3]))) + (((c[0] + c[1]) + (c[2] + c[3])) + ((d[0] + d[1]) + (d[2] + d[3])));
    return 1.0f / sqrtf(s * (1.0f / 1024.0f) + EPS);
}
__device__ __forceinline__ float silu_f(float x) { return x * __builtin_amdgcn_rcpf(1.0f + __builtin_amdgcn_exp2f(-x * LOG2E)); }

struct EpiRowScaleBf16 {
    static constexpr bool PERM = true, AFTER_DRAIN = false;
    bf16_t* O; int ldc; const float* part; int split_cols; bf16_t* O1; bf16_t* O2;
    __device__ __forceinline__ void operator()(const f32x4 (&acc)[2][2][4][2], const Unit& u, int wr, int wc, int fr, int fq) const {
        const int row0 = u.pm * BM + wr * 64 + fr; int colt = u.pn * BM; bf16_t* base = O;
        if (split_cols) { const int t = colt / split_cols; base = (t == 0) ? O : (t == 1 ? O1 : O2); colt -= t * split_cols; }
        const int col0 = colt + wc * 32 + 8 * fq;
#pragma unroll
        for (int ai = 0; ai < 2; ++ai)
#pragma unroll
            for (int m = 0; m < 4; ++m) { const int row = row0 + ai * HALF + m * 16; const float rs = rstd_row(part, row); bf16_t* rowp = base + (size_t)row * ldc + col0;
#pragma unroll
                for (int bj = 0; bj < 2; ++bj) { const f32x4 v0 = acc[ai][bj][m][0] * rs, v1 = acc[ai][bj][m][1] * rs;
                    u32x4 w; w.x = cvt_pk_bf16(v0[0], v0[1]); w.y = cvt_pk_bf16(v0[2], v0[3]); w.z = cvt_pk_bf16(v1[0], v1[1]); w.w = cvt_pk_bf16(v1[2], v1[3]);
                    *(u32x4*)(rowp + bj * HALF) = w; }
                asm volatile("" ::: "memory"); }
    }
};
struct EpiSwiglu {
    static constexpr bool PERM = true, AFTER_DRAIN = false;
    bf16_t* O; int ldc; const float* part;
    __device__ __forceinline__ void operator()(const f32x4 (&acc)[2][2][4][2], const Unit& u, int wr, int wc, int fr, int fq) const {
        const int row0 = u.pm * BM + wr * 64 + fr; const int col0 = u.pn * HALF + wc * 32 + 8 * fq;
#pragma unroll
        for (int ai = 0; ai < 2; ++ai)
#pragma unroll
            for (int m = 0; m < 4; ++m) { const int row = row0 + ai * HALF + m * 16; const float rs = rstd_row(part, row);
                const f32x4 g0 = acc[ai][0][m][0] * rs, g1 = acc[ai][0][m][1] * rs, u0 = acc[ai][1][m][0] * rs, u1 = acc[ai][1][m][1] * rs;
                float a[8];
#pragma unroll
                for (int i = 0; i < 4; ++i) { a[i] = silu_f(g0[i]) * u0[i]; a[4 + i] = silu_f(g1[i]) * u1[i]; }
                u32x4 w; w.x = cvt_pk_bf16(a[0], a[1]); w.y = cvt_pk_bf16(a[2], a[3]); w.z = cvt_pk_bf16(a[4], a[5]); w.w = cvt_pk_bf16(a[6], a[7]);
                *(u32x4*)(O + (size_t)row * ldc + col0) = w;
                asm volatile("" ::: "memory"); }
    }
};
struct EpiResid {
    static constexpr bool PERM = true, AFTER_DRAIN = false;
    const float* base32; bf16_t* hi; bf16_t* lo; float* part_out;
    __device__ __forceinline__ void operator()(const f32x4 (&acc)[2][2][4][2], const Unit& u, int wr, int wc, int fr, int fq) const {
        const int row0 = u.pm * BM + wr * 64 + fr, col0 = u.pn * BM + wc * 32 + 8 * fq;
#pragma unroll
        for (int ai = 0; ai < 2; ++ai)
#pragma unroll
            for (int m = 0; m < 4; ++m) { const int row = row0 + ai * HALF + m * 16; const size_t off = (size_t)row * DM + col0; float ss = 0.f;
#pragma unroll
                for (int bj = 0; bj < 2; ++bj) {
                    float h[8];
                    if (base32) { const f32x4 b0 = *(const f32x4*)(base32 + off + bj * HALF), b1 = *(const f32x4*)(base32 + off + bj * HALF + 4);
#pragma unroll
                        for (int i = 0; i < 4; ++i) { h[i] = b0[i]; h[4 + i] = b1[i]; } }
                    else { const u32x4 a = *(const u32x4*)(hi + off + bj * HALF), b = *(const u32x4*)(lo + off + bj * HALF);
#pragma unroll
                        for (int i = 0; i < 4; ++i) { h[2 * i] = __builtin_bit_cast(float, a[i] << 16) + __builtin_bit_cast(float, b[i] << 16); h[2 * i + 1] = __builtin_bit_cast(float, a[i] & 0xffff0000u) + __builtin_bit_cast(float, b[i] & 0xffff0000u); } }
#pragma unroll
                    for (int i = 0; i < 4; ++i) { h[i] += acc[ai][bj][m][0][i]; h[4 + i] += acc[ai][bj][m][1][i]; }
                    u32x4 wh, wl;
#pragma unroll
                    for (int i = 0; i < 4; ++i) { ss += h[2 * i] * h[2 * i] + h[2 * i + 1] * h[2 * i + 1];
                        const unsigned ph = cvt_pk_bf16(h[2 * i], h[2 * i + 1]);
                        const float r0 = h[2 * i] - __builtin_bit_cast(float, ph << 16), r1 = h[2 * i + 1] - __builtin_bit_cast(float, ph & 0xffff0000u);
                        wh[i] = ph; wl[i] = cvt_pk_bf16(r0, r1); }
                    *(u32x4*)(hi + off + bj * HALF) = wh; *(u32x4*)(lo + off + bj * HALF) = wl; }
                ss += __shfl_xor(ss, 16); ss += __shfl_xor(ss, 32);
                if (fq == 0) part_out[(size_t)row * 16 + u.pn * 4 + wc] = ss;
                asm volatile("" ::: "memory"); }
    }
};

template <class Epi, class Sched, bool ALIGN_EPI = false, bool SP2 = false>
__device__ __forceinline__ void gemm_phase(PG8_LAS unsigned char* lds, const Gemm g, const Sched& S, const Epi& E) {
    int tid_ = threadIdx.x; asm volatile("" : "+v"(tid_));
    const int tid = tid_, wid = __builtin_amdgcn_readfirstlane(tid >> 6), lane = tid & 63, wr = wid >> 2, wc = wid & 3, fr = lane & 15, fq = lane >> 4;
    const int K = g.K, nt = K / BK;
    unsigned voffA[2], voffB[2];
#pragma unroll
    for (int i = 0; i < 2; ++i) { int R, C; stage_rc(tid * 16 + i * 8192, R, C); const int Rb = Epi::PERM ? ((R & ~31) + perm32(R & 31)) : R;
        voffA[i] = (unsigned)(R * K + C) * 2u; voffB[i] = (unsigned)(Rb * K + C) * 2u; }
    const size_t kstep = (size_t)(BK * 2);
    const size_t hstep = (size_t)HALF * K * 2;
    const size_t tstep = 2 * hstep;
    const unsigned ldsw = (unsigned)wid * 1024u;
    const int aoff = lds_byte(wr * 64 + fr, fq * 8), boff = lds_byte(wc * 32 + fr, fq * 8);
#define PG8_SA(b, h) (((b) * 2 + (h)) * HTB)
#define PG8_SB(b, h) ((4 + (b) * 2 + (h)) * HTB)
#define PG8_STAGE(bufoff, gbase, voff) do { _Pragma("unroll") for (int _i = 0; _i < 2; ++_i) \
        __builtin_amdgcn_global_load_lds((const unsigned*)((const char*)(gbase) + (voff)[_i]), (PG8_LAS unsigned*)(lds + (bufoff) + ldsw + _i * 8192), 16, 0, 0); } while (0)
#define PG8_LDA(dst, b, h) do { _Pragma("unroll") for (int m = 0; m < 4; ++m) _Pragma("unroll") for (int k = 0; k < 2; ++k) dst[m][k] = *(const PG8_LAS bf16x8*)(lds + PG8_SA(b, h) + aoff + m * 2048 + k * 1024); } while (0)
#define PG8_LDB(dst, b, h) do { _Pragma("unroll") for (int n = 0; n < 2; ++n) _Pragma("unroll") for (int k = 0; k < 2; ++k) dst[n][k] = *(const PG8_LAS bf16x8*)(lds + PG8_SB(b, h) + boff + n * 2048 + k * 1024); } while (0)
#define PG8_MMA(ai, bj, At, Bt) do { __builtin_amdgcn_s_setprio(1); _Pragma("unroll") for (int m = 0; m < 4; ++m) _Pragma("unroll") for (int n = 0; n < 2; ++n) _Pragma("unroll") for (int k = 0; k < 2; ++k) \
        acc[ai][bj][m][n] = __builtin_amdgcn_mfma_f32_16x16x32_bf16(Bt[n][k], At[m][k], acc[ai][bj][m][n], 0, 0, 0); __builtin_amdgcn_s_setprio(0); } while (0)
#define PG8_WAIT_V(n) asm volatile("s_waitcnt vmcnt(" #n ")" ::: "memory")
#define PG8_WAIT_L(n) asm volatile("s_waitcnt lgkmcnt(" #n ")" ::: "memory")
#define PG8_BAR __builtin_amdgcn_s_barrier()
#define PG8_SCHED __builtin_amdgcn_sched_barrier(0)
    Unit cur, nxt; int ui = 0;
    if (!S.next(0, cur)) return;
    f32x4 acc[2][2][4][2];
#pragma unroll
    for (int a = 0; a < 2; ++a)
#pragma unroll
        for (int b = 0; b < 2; ++b)
#pragma unroll
            for (int m = 0; m < 4; ++m)
#pragma unroll
                for (int n = 0; n < 2; ++n) acc[a][b][m][n] = (f32x4){0.f, 0.f, 0.f, 0.f};
    bf16x8 At[4][2], B0[2][2], B1[2][2];
    const char* cA = (const char*)g.A + (size_t)cur.pm * tstep; const char* cB = (const char*)g.Bt + (size_t)cur.pn * tstep;
    S.a_ready(cur);
    if constexpr (SP2) {
        PG8_STAGE(PG8_SB(0, 0), cB, voffB); PG8_STAGE(PG8_SB(0, 1), cB + hstep, voffB); PG8_STAGE(PG8_SA(0, 0), cA, voffA); PG8_STAGE(PG8_SA(0, 1), cA + hstep, voffA);
        if (wr == 1) PG8_BAR;
        PG8_WAIT_V(2); PG8_BAR;
        PG8_STAGE(PG8_SB(1, 0), cB + kstep, voffB); PG8_STAGE(PG8_SA(1, 0), cA + kstep, voffA); PG8_STAGE(PG8_SB(1, 1), cB + hstep + kstep, voffB);
        PG8_WAIT_V(6); PG8_BAR;
    } else {
        PG8_STAGE(PG8_SB(0, 0), cB, voffB); PG8_STAGE(PG8_SA(0, 0), cA, voffA); PG8_STAGE(PG8_SB(0, 1), cB + hstep, voffB); PG8_STAGE(PG8_SA(0, 1), cA + hstep, voffA);
        if (wr == 1) PG8_BAR;
        PG8_WAIT_V(4); PG8_BAR;
        PG8_STAGE(PG8_SB(1, 0), cB + kstep, voffB); PG8_STAGE(PG8_SA(1, 0), cA + kstep, voffA); PG8_STAGE(PG8_SB(1, 1), cB + hstep + kstep, voffB);
        PG8_WAIT_V(6); PG8_BAR;
    }
    for (;;) {
        const bool has_next = S.next(ui + 1, nxt);
        const char* nA = has_next ? (const char*)g.A + (size_t)nxt.pm * tstep : cA; const char* nB = has_next ? (const char*)g.Bt + (size_t)nxt.pn * tstep : cB;
        for (int t = 0; t < nt; t += 2) {
            const bool last = (t == nt - 2);
            const char* a1 = cA + (size_t)(t + 1) * kstep;
            const char* a2 = last ? nA : cA + (size_t)(t + 2) * kstep; const char* b2 = last ? nB : cB + (size_t)(t + 2) * kstep;
            const char* a3 = a2 + kstep; const char* b3 = b2 + kstep;
            if (last && has_next) S.a_ready(nxt);
            if constexpr (SP2) {
            PG8_LDB(B0, 0, 0); PG8_LDB(B1, 0, 1); PG8_SCHED; PG8_LDA(At, 0, 0); PG8_STAGE(PG8_SA(1, 1), a1 + hstep, voffA);
            PG8_WAIT_V(8); PG8_WAIT_L(0); PG8_BAR; PG8_MMA(0, 0, At, B0); PG8_MMA(0, 1, At, B1); PG8_BAR; PG8_SCHED;
            PG8_LDA(At, 0, 1); PG8_STAGE(PG8_SB(0, 0), b2, voffB); PG8_STAGE(PG8_SB(0, 1), b2 + hstep, voffB); PG8_STAGE(PG8_SA(0, 0), a2, voffA);
            PG8_WAIT_V(8); PG8_WAIT_L(0); PG8_BAR; PG8_MMA(1, 0, At, B0); PG8_MMA(1, 1, At, B1); PG8_BAR; PG8_SCHED;
            PG8_LDB(B0, 1, 0); PG8_LDB(B1, 1, 1); PG8_SCHED; PG8_LDA(At, 1, 0); PG8_STAGE(PG8_SA(0, 1), a2 + hstep, voffA);
            PG8_WAIT_V(8); PG8_WAIT_L(0); PG8_BAR; PG8_MMA(0, 0, At, B0); PG8_MMA(0, 1, At, B1); PG8_BAR; PG8_SCHED;
            PG8_LDA(At, 1, 1); PG8_STAGE(PG8_SB(1, 0), b3, voffB); PG8_STAGE(PG8_SB(1, 1), b3 + hstep, voffB); PG8_STAGE(PG8_SA(1, 0), a3, voffA);
            PG8_WAIT_V(8); PG8_WAIT_L(0); PG8_BAR; PG8_MMA(1, 0, At, B0); PG8_MMA(1, 1, At, B1); PG8_BAR; PG8_SCHED;
            } else {
            PG8_LDB(B0, 0, 0); PG8_SCHED; PG8_LDA(At, 0, 0); PG8_STAGE(PG8_SA(1, 1), a1 + hstep, voffA);
            PG8_WAIT_L(8); PG8_BAR; PG8_WAIT_L(0); PG8_MMA(0, 0, At, B0); PG8_BAR; PG8_SCHED;
            PG8_LDB(B1, 0, 1); PG8_STAGE(PG8_SB(0, 0), b2, voffB);
            PG8_BAR; PG8_WAIT_L(0); PG8_MMA(0, 1, At, B1); PG8_BAR;
            PG8_LDA(At, 0, 1); PG8_STAGE(PG8_SA(0, 0), a2, voffA);
            PG8_BAR; PG8_WAIT_L(0); PG8_MMA(1, 0, At, B0); PG8_BAR; PG8_SCHED;
            PG8_STAGE(PG8_SB(0, 1), b2 + hstep, voffB);
            PG8_WAIT_V(6); PG8_BAR; PG8_MMA(1, 1, At, B1); PG8_BAR;
            PG8_LDB(B0, 1, 0); PG8_SCHED; PG8_LDA(At, 1, 0); PG8_STAGE(PG8_SA(0, 1), a2 + hstep, voffA);
            PG8_WAIT_L(8); PG8_BAR; PG8_WAIT_L(0); PG8_MMA(0, 0, At, B0); PG8_BAR; PG8_SCHED;
            PG8_LDB(B1, 1, 1); PG8_STAGE(PG8_SB(1, 0), b3, voffB);
            PG8_BAR; PG8_WAIT_L(0); PG8_MMA(0, 1, At, B1); PG8_BAR;
            PG8_LDA(At, 1, 1); PG8_STAGE(PG8_SA(1, 0), a3, voffA);
            PG8_BAR; PG8_WAIT_L(0); PG8_MMA(1, 0, At, B0); PG8_BAR; PG8_SCHED;
            PG8_STAGE(PG8_SB(1, 1), b3 + hstep, voffB);
            PG8_WAIT_V(6); PG8_BAR; PG8_MMA(1, 1, At, B1); PG8_BAR;
            }
        }
        if constexpr (ALIGN_EPI) { if (wr == 0) PG8_BAR; }
        if constexpr (!Epi::AFTER_DRAIN) { E(acc, cur, wr, wc, fr, fq); S.done(cur); }
        if (!has_next) break;
#pragma unroll
        for (int a = 0; a < 2; ++a)
#pragma unroll
            for (int b = 0; b < 2; ++b)
#pragma unroll
                for (int m = 0; m < 4; ++m)
#pragma unroll
                    for (int n = 0; n < 2; ++n) acc[a][b][m][n] = (f32x4){0.f, 0.f, 0.f, 0.f};
        cur = nxt; cA = nA; cB = nB; ++ui;
        if constexpr (ALIGN_EPI) { if (wr == 1) PG8_BAR; }
    }
    PG8_WAIT_V(0);
    if constexpr (!ALIGN_EPI) { if (wr == 0) PG8_BAR; }
    PG8_BAR;
#undef PG8_SA
#undef PG8_SB
#undef PG8_STAGE
#undef PG8_LDA
#undef PG8_LDB
#undef PG8_MMA
#undef PG8_WAIT_V
#undef PG8_WAIT_L
#undef PG8_BAR
#undef PG8_SCHED
}
}

namespace attn_body {
using bf16=__hip_bfloat16;
using bf16x8=__attribute__((ext_vector_type(8)))short;
using s16x4=__attribute__((ext_vector_type(4)))short;
using f32x16=__attribute__((ext_vector_type(16)))float;
using f32x4=__attribute__((ext_vector_type(4)))float;
using u32x4=__attribute__((ext_vector_type(4)))unsigned;
constexpr int NHEAD=16,D=64,DMA=NHEAD*D;
constexpr int NW=8,QBLK=32,QB=QBLK*NW,KVBLK=64,NQB=SEQ/QB;
__device__ __forceinline__ int crow(int r,int hi){return (r&3)+8*(r>>2)+4*hi;}
#define SBAR() __builtin_amdgcn_sched_barrier(0)
__device__ __forceinline__ void cmask(f32x16&p0,f32x16&p1,int jb,int qrel,int hi){
  const float NEG=-INFINITY; int kb=64*jb+4*hi;
  #pragma unroll
  for(int r=0;r<16;++r){int kv=kb+(r&3)+8*(r>>2); if(kv>qrel)p0[r]=NEG; if(kv+32>qrel)p1[r]=NEG;}
}
constexpr int NSLOT=3, SLOTB=8192;
constexpr int LDS_K=0, LDS_V=NSLOT*SLOTB, LDS_WS=2*NSLOT*SLOTB, LDS_OST=LDS_WS+NW*64*4, LDS_BYTES=LDS_OST+NW*4096;
constexpr int LDS_BIAS=LDS_BYTES, LDS_BIAS_BYTES=SEQ*4, LDS_SCAN=LDS_BIAS+LDS_BIAS_BYTES, LDS_TOTAL=LDS_SCAN+64;
__device__ __forceinline__ void glds16(const void*gsrc,unsigned lds_dst){unsigned keep;
  asm volatile("s_mov_b32 %0, m0\n\ts_mov_b32 m0, %2\n\ts_nop 0\n\tglobal_load_lds_dwordx4 %1, off\n\ts_mov_b32 m0, %0":"=&s"(keep):"v"(gsrc),"s"(lds_dst):"memory");}
__device__ __forceinline__ float max3f(float a,float b,float c){float r;asm("v_max3_f32 %0, %1, %2, %3":"=v"(r):"v"(a),"v"(b),"v"(c));return r;}
__device__ __forceinline__ float max2f(float a,float b){float r;asm("v_max_f32_e32 %0, %1, %2":"=v"(r):"v"(a),"v"(b));return r;}
__device__ __forceinline__ float fadd_s(float a,float b){float r;asm("v_add_f32_e32 %0, %1, %2":"=v"(r):"v"(a),"v"(b));return r;}
__device__ __forceinline__ float fsub_s(float a,float b){float r;asm("v_sub_f32_e32 %0, %1, %2":"=v"(r):"v"(a),"v"(b));return r;}
typedef float f32x2_t __attribute__((ext_vector_type(2))); typedef __bf16 bf16x2_t __attribute__((ext_vector_type(2)));
__device__ __forceinline__ unsigned cvtpk_s(float lo,float hi){f32x2_t v={lo,hi};bf16x2_t b=__builtin_convertvector(v,bf16x2_t);return __builtin_bit_cast(unsigned,b);}
#define WAIT_BAR(N) asm volatile("s_waitcnt vmcnt(" #N ") lgkmcnt(0)\n\ts_barrier":::"memory")

__device__ __forceinline__ void qkt(f32x16&p0,f32x16&p1,const char*Kslot,const bf16x8*qr,int r32,int hi){
  const f32x16 negm=f32x16{};
  const char*kb=Kslot+hi*1024+r32*16;
  #pragma unroll
  for(int d0=0;d0<4;++d0){
    const bf16x8 b0=*reinterpret_cast<const bf16x8*>(kb+d0*2048);
    const bf16x8 b1=*reinterpret_cast<const bf16x8*>(kb+d0*2048+512);
    if(d0==0){p0=__builtin_amdgcn_mfma_f32_32x32x16_bf16(b0,qr[0],negm,0,0,0);p1=__builtin_amdgcn_mfma_f32_32x32x16_bf16(b1,qr[0],negm,0,0,0);}
    else{p0=__builtin_amdgcn_mfma_f32_32x32x16_bf16(b0,qr[d0],p0,0,0,0);p1=__builtin_amdgcn_mfma_f32_32x32x16_bf16(b1,qr[d0],p1,0,0,0);}}
}
typedef __attribute__((address_space(3))) const char* lds_cptr;
typedef short v4i16_t __attribute__((ext_vector_type(4)));
__device__ __forceinline__ void kload8(bf16x8*kf,lds_cptr kp){
  kf[0]=*(const __attribute__((address_space(3))) bf16x8*)(kp);      kf[1]=*(const __attribute__((address_space(3))) bf16x8*)(kp+512);
  kf[2]=*(const __attribute__((address_space(3))) bf16x8*)(kp+2048); kf[3]=*(const __attribute__((address_space(3))) bf16x8*)(kp+2560);
  kf[4]=*(const __attribute__((address_space(3))) bf16x8*)(kp+4096); kf[5]=*(const __attribute__((address_space(3))) bf16x8*)(kp+4608);
  kf[6]=*(const __attribute__((address_space(3))) bf16x8*)(kp+6144); kf[7]=*(const __attribute__((address_space(3))) bf16x8*)(kp+6656);
}
__device__ __forceinline__ void kload2(bf16x8*kf,lds_cptr kp,int j){ kf[2*j]=*(const __attribute__((address_space(3))) bf16x8*)(kp+j*2048); kf[2*j+1]=*(const __attribute__((address_space(3))) bf16x8*)(kp+j*2048+512); }
__device__ __forceinline__ s16x4 vtr(lds_cptr p){ return __builtin_bit_cast(s16x4,__builtin_amdgcn_ds_read_tr16_b64_v4i16((__attribute__((address_space(3))) v4i16_t*)p)); }
__device__ __forceinline__ float rowmax(const f32x16&p0,const f32x16&p1){
  float a=max3f(p0[0],p0[1],p1[0]),b=max3f(p0[2],p0[3],p1[1]);a=max3f(a,p1[2],p1[3]);
  #pragma unroll
  for(int r=4;r<16;r+=4){a=max3f(a,p0[r],p0[r+1]);b=max3f(b,p0[r+2],p0[r+3]);a=max3f(a,p1[r],p1[r+1]);b=max3f(b,p1[r+2],p1[r+3]);}
  const float m=max2f(a,b);
  auto rr=__builtin_amdgcn_permlane32_swap(__float_as_uint(m),__float_as_uint(m),false,false);
  return max2f(__uint_as_float(rr[0]),__uint_as_float(rr[1]));
}
__device__ __forceinline__ void pv(f32x16*o,int vb,bf16x8 pa0,bf16x8 pa1,bf16x8 pa2,bf16x8 pa3){
  #pragma unroll
  for(int d0=0;d0<2;++d0){s16x4 lo[4],hi[4];
    #pragma unroll
    for(int ks=0;ks<4;++ks){
      asm volatile("ds_read_b64_tr_b16 %0,%1 offset:%c2":"=&v"(lo[ks]):"v"(vb),"i"(d0*4096+ks*1024):"memory");
      asm volatile("ds_read_b64_tr_b16 %0,%1 offset:%c2":"=&v"(hi[ks]):"v"(vb),"i"(d0*4096+ks*1024+512):"memory");}
    asm volatile("s_waitcnt lgkmcnt(0)":::"memory");SBAR();
    #define PK(k) (bf16x8){lo[k][0],lo[k][1],lo[k][2],lo[k][3],hi[k][0],hi[k][1],hi[k][2],hi[k][3]}
    o[d0]=__builtin_amdgcn_mfma_f32_32x32x16_bf16(pa0,PK(0),o[d0],0,0,0);
    o[d0]=__builtin_amdgcn_mfma_f32_32x32x16_bf16(pa1,PK(1),o[d0],0,0,0);
    o[d0]=__builtin_amdgcn_mfma_f32_32x32x16_bf16(pa2,PK(2),o[d0],0,0,0);
    o[d0]=__builtin_amdgcn_mfma_f32_32x32x16_bf16(pa3,PK(3),o[d0],0,0,0);
    #undef PK
  }
}
__device__ __forceinline__ void kbias(f32x16&p0,f32x16&p1,const __attribute__((address_space(3))) float*bt,int t,int hi,float mh){
  const __attribute__((address_space(3))) f32x4*b4=(const __attribute__((address_space(3))) f32x4*)(bt+64*t+4*hi);
  #pragma unroll
  for(int g=0;g<4;++g){ const f32x4 x=b4[2*g], y=b4[2*g+8];
    #pragma unroll
    for(int i=0;i<4;++i){p0[4*g+i]+=x[i]-mh;p1[4*g+i]+=y[i]-mh;} }
}

#ifndef ATTN_STORE16
#define ATTN_STORE16(p,v) (*(u32x4*)(p)=(v))
#endif
template<int THRL> __device__ __forceinline__ void attn_unit(int b,int h,int qb,const bf16*Q,const bf16*__restrict__ K,const bf16*__restrict__ V,bf16*O,char*shm){
  int tid_=threadIdx.x; asm volatile("":"+v"(tid_));
  const int tid=tid_,lane=tid&63,r32=lane&31,hi=lane>>5; const int wid=__builtin_amdgcn_readfirstlane(tid>>6);
  const long rowbase=(long)b*SEQ; const int q0=qb*QB;
  const bf16*Qw=Q+(rowbase+q0+wid*QBLK)*DMA+h*D;
  const bf16*Kh=K+rowbase*DMA+h*D,*Vh=V+rowbase*DMA+h*D;
  const unsigned lds0=(unsigned)(uintptr_t)shm;
  float*wsf=(float*)(shm+LDS_WS)+wid*64;
  const __attribute__((address_space(3))) float*bt=(const __attribute__((address_space(3))) float*)((lds_cptr)shm+LDS_BIAS);
  const bf16*ksrc=Kh+(long)lane*DMA+wid*8;
  const bf16*vsrc=Vh+(long)(16*(wid&3)+(lane>>2))*DMA+(wid>>2)*32+(lane&3)*8;
  const unsigned kdst=lds0+LDS_K+wid*1024, vdst=lds0+LDS_V+wid*1024;
  #define DMA_K(t,slot) glds16(ksrc+(long)(t)*KVBLK*DMA,(unsigned)__builtin_amdgcn_readfirstlane(kdst+(slot)))
  #define DMA_V(t,slot) glds16(vsrc+(long)(t)*KVBLK*DMA,(unsigned)__builtin_amdgcn_readfirstlane(vdst+(slot)))
  const int vb0=(int)(lds0+LDS_V)+((lane>>4)&1)*32+(lane&3)*8+(4*hi+((lane&15)>>2))*64;
  const char*Kbase=shm+LDS_K; bf16x8 kf[8];
  const lds_cptr shm3=(lds_cptr)shm; const lds_cptr kp0=shm3+LDS_K+hi*1024+r32*16; const lds_cptr vp0=shm3+LDS_V+((lane>>4)&1)*32+(lane&3)*8+(4*hi+((lane&15)>>2))*64;
  const int NT=(q0+QB)/KVBLK;
  DMA_K(0,0);DMA_V(0,0);DMA_K(1,SLOTB);
  bf16x8 qr[4];
  #pragma unroll
  for(int d0=0;d0<4;++d0)qr[d0]=*reinterpret_cast<const bf16x8*>(&Qw[(long)r32*DMA+d0*16+hi*8]);
  const int qrel=wid*QBLK+r32;
  float mhat=bt[q0+qrel],l_reg=0.f;f32x16 o[2];o[0]=f32x16{};o[1]=f32x16{};
  const f32x16 zero16=f32x16{};
  #define CMASK(P0,P1,t) do{int jb_=(t)-(NT-4); if(jb_>=0)cmask(P0,P1,jb_,qrel,hi);}while(0)
  bool resc=false;
  #define START(P0,P1) do{ const float rm=rowmax(P0,P1); resc=false; \
    { const float dl=rm; mhat=fadd_s(mhat,dl); \
      _Pragma("unroll") for(int r=0;r<16;++r){P0[r]=fsub_s(P0[r],dl);P1[r]=fsub_s(P1[r],dl);} } \
    _Pragma("unroll") for(int r=0;r<16;++r)P0[r]=__builtin_amdgcn_exp2f(P0[r]); }while(0)
  #define RESC() do{ if(resc){ asm volatile("s_waitcnt lgkmcnt(0)":::"memory"); \
      _Pragma("unroll") for(int d_=0;d_<2;++d_) _Pragma("unroll") for(int r=0;r<16;++r)o[d_][r]*=wsf[crow(r,hi)]; } }while(0)
  f32x16 pA0,pA1,pB0,pB1;
  int sl_prev=0,sl_cur=0,sl_next=SLOTB;
  #define ROT() do{sl_prev=sl_cur;sl_cur=sl_next;sl_next=(sl_next==(NSLOT-1)*SLOTB)?0:sl_next+SLOTB;}while(0)
  DMA_K(2,2*SLOTB);
  WAIT_BAR(3);
  qkt(pA0,pA1,Kbase,qr,r32,hi);asm volatile("s_nop 15\n\ts_nop 7":"+v"(pA0),"+v"(pA1));kbias(pA0,pA1,bt,0,hi,mhat);CMASK(pA0,pA1,0);
  START(pA0,pA1);
  _Pragma("unroll") for(int r=0;r<16;++r)pA1[r]=__builtin_amdgcn_exp2f(pA1[r]);
  WAIT_BAR(0);
  DMA_K(3,0);DMA_V(1,SLOTB);
  ROT();
  kload8(kf,kp0+sl_cur);
  WAIT_BAR(2);
  s16x4 vlo[8],vhi[8]; u32x4 pw0,pw1,pw2,pw3;
  #define PKW(P,B) cvtpk_s(P[B],P[B+1])
  #define PAF(k) __builtin_bit_cast(bf16x8,pw##k)
  #define VFR(i) (bf16x8){vlo[i][0],vlo[i][1],vlo[i][2],vlo[i][3],vhi[i][0],vhi[i][1],vhi[i][2],vhi[i][3]}
  #define PIN(x) asm volatile("":"+v"(x))
  #define MX3(a,b,c) __builtin_fmaxf(__builtin_fmaxf((a),(b)),(c))
  #define GAPA(MF,A0,A1,A2,A3,W0,W1,PW) do{ MF; sacc+=A0; sacc+=A1; sacc+=A2; sacc+=A3; PIN(sacc); W0; W1; PIN(PW); SBAR(); }while(0)
  #define EX(v) __builtin_amdgcn_exp2f(v)
  #define GAPB(MF,X,B) do{ MF; X[B]=EX(X[B]); X[B+1]=EX(X[B+1]); X[B+2]=EX(X[B+2]); X[B+3]=EX(X[B+3]); PIN(X); SBAR(); }while(0)
  #define VRD(i) do{ vlo[i]=vtr(vp_+(((i)>>2)*4096+((i)&3)*1024)); vhi[i]=vtr(vp_+(((i)>>2)*4096+((i)&3)*1024+512)); }while(0)
  #define KRD(G,j) do{ if(G){ kload2(kf,kp0+sl_next,j); SBAR(); } }while(0)
  #define STEP(C0,C1,P0,P1,t,GK,GV,GL) do{ SBAR(); \
    const lds_cptr vp_=vp0+sl_prev; \
    VRD(0); SBAR(); float sacc=(P0[0]+P0[1]); \
    GAPA(C0=__builtin_amdgcn_mfma_f32_32x32x16_bf16(kf[0],qr[0],zero16,0,0,0), P0[2],P0[3],P0[4],P0[5],     pw0[0]=PKW(P0,0), pw0[1]=PKW(P0,2), pw0); \
    VRD(4); SBAR(); GAPA(C1=__builtin_amdgcn_mfma_f32_32x32x16_bf16(kf[1],qr[0],zero16,0,0,0), P0[6],P0[7],P0[8],P0[9],     pw0[2]=PKW(P0,4), pw0[3]=PKW(P0,6), pw0); \
    VRD(1); SBAR(); GAPA(C0=__builtin_amdgcn_mfma_f32_32x32x16_bf16(kf[2],qr[1],C0,0,0,0),   P0[10],P0[11],P0[12],P0[13], pw1[0]=PKW(P0,8), pw1[1]=PKW(P0,10), pw1); \
    VRD(5); SBAR(); GAPA(C1=__builtin_amdgcn_mfma_f32_32x32x16_bf16(kf[3],qr[1],C1,0,0,0),   P0[14],P0[15],P1[0],P1[1],   pw1[2]=PKW(P0,12),pw1[3]=PKW(P0,14), pw1); \
    VRD(2); SBAR(); GAPA(C0=__builtin_amdgcn_mfma_f32_32x32x16_bf16(kf[4],qr[2],C0,0,0,0),   P1[2],P1[3],P1[4],P1[5],     pw2[0]=PKW(P1,0), pw2[1]=PKW(P1,2), pw2); \
    VRD(6); SBAR(); GAPA(C1=__builtin_amdgcn_mfma_f32_32x32x16_bf16(kf[5],qr[2],C1,0,0,0),   P1[6],P1[7],P1[8],P1[9],     pw2[2]=PKW(P1,4), pw2[3]=PKW(P1,6), pw2); \
    VRD(3); SBAR(); GAPA(C0=__builtin_amdgcn_mfma_f32_32x32x16_bf16(kf[6],qr[3],C0,0,0,0),   P1[10],P1[11],P1[12],P1[13], pw3[0]=PKW(P1,8), pw3[1]=PKW(P1,10), pw3); \
    VRD(7); SBAR(); GAPA(C1=__builtin_amdgcn_mfma_f32_32x32x16_bf16(kf[7],qr[3],C1,0,0,0),   P1[14],P1[15],0.f,0.f,       pw3[2]=PKW(P1,12),pw3[3]=PKW(P1,14), pw3); \
    l_reg+=sacc; \
    if(GK){DMA_K((t)+3,sl_cur);} if(GV){DMA_V((t)+1,sl_next);} \
    kbias(C0,C1,bt,t,hi,mhat); \
    CMASK(C0,C1,t); \
    { float a=MX3(C0[0],C0[1],C1[0]),b=MX3(C0[2],C0[3],C1[1]); a=MX3(a,C1[2],C1[3]); \
      _Pragma("unroll") for(int r=4;r<16;r+=4){a=MX3(a,C0[r],C0[r+1]);b=MX3(b,C0[r+2],C0[r+3]);a=MX3(a,C1[r],C1[r+1]);b=MX3(b,C1[r+2],C1[r+3]);} \
      float rm=__builtin_fmaxf(a,b); { auto rr=__builtin_amdgcn_permlane32_swap(__float_as_uint(rm),__float_as_uint(rm),false,false); rm=__builtin_fmaxf(__uint_as_float(rr[0]),__uint_as_float(rr[1])); } \
      resc=false; \
      if(__builtin_expect(__any(rm>(float)THRL),0)){ const float dl=__builtin_fmaxf(rm,0.f); mhat+=dl; \
        _Pragma("unroll") for(int r=0;r<16;++r){C0[r]-=dl;C1[r]-=dl;} \
        const float f=__builtin_amdgcn_exp2f(-dl); l_reg*=f; if(hi==0)wsf[r32]=f; resc=true; } } \
    SBAR(); \
    GAPB(o[0]=__builtin_amdgcn_mfma_f32_32x32x16_bf16(PAF(0),VFR(0),o[0],0,0,0), C0,0); \
    GAPB(o[1]=__builtin_amdgcn_mfma_f32_32x32x16_bf16(PAF(0),VFR(4),o[1],0,0,0), C0,4); \
    KRD(GL,0); GAPB(o[0]=__builtin_amdgcn_mfma_f32_32x32x16_bf16(PAF(1),VFR(1),o[0],0,0,0), C0,8); \
    KRD(GL,1); GAPB(o[1]=__builtin_amdgcn_mfma_f32_32x32x16_bf16(PAF(1),VFR(5),o[1],0,0,0), C0,12); \
    KRD(GL,2); GAPB(o[0]=__builtin_amdgcn_mfma_f32_32x32x16_bf16(PAF(2),VFR(2),o[0],0,0,0), C1,0); \
    KRD(GL,3); GAPB(o[1]=__builtin_amdgcn_mfma_f32_32x32x16_bf16(PAF(2),VFR(6),o[1],0,0,0), C1,4); \
    GAPB(o[0]=__builtin_amdgcn_mfma_f32_32x32x16_bf16(PAF(3),VFR(3),o[0],0,0,0), C1,8); \
    GAPB(o[1]=__builtin_amdgcn_mfma_f32_32x32x16_bf16(PAF(3),VFR(7),o[1],0,0,0), C1,12); \
    }while(0)
  int t=1;
  #undef CMASK
  #define CMASK(P0,P1,t) do{}while(0)
  for(;t+5<NT;t+=2){
    STEP(pB0,pB1,pA0,pA1,t,true,true,true);     WAIT_BAR(2); RESC(); ROT();
    STEP(pA0,pA1,pB0,pB1,t+1,true,true,true);   WAIT_BAR(2); RESC(); ROT();
  }
  #undef CMASK
  #define CMASK(P0,P1,t) do{int jb_=(t)-(NT-4); if(jb_>=0)cmask(P0,P1,jb_,qrel,hi);}while(0)
  #define ENDW(tt) do{ if((tt)+3<NT){WAIT_BAR(2);} else if((tt)+2<NT){WAIT_BAR(1);} else {WAIT_BAR(0);} }while(0)
  for(;t+1<NT;t+=2){
    STEP(pB0,pB1,pA0,pA1,t,(t+3<NT),(t+1<NT),(t+1<NT));       ENDW(t);   RESC(); ROT();
    STEP(pA0,pA1,pB0,pB1,t+1,(t+4<NT),(t+2<NT),(t+2<NT));     ENDW(t+1); RESC(); ROT();
  }
  STEP(pB0,pB1,pA0,pA1,NT-1,false,false,false); RESC();
  { float sacc=pB0[0]+pB0[1]; _Pragma("unroll") for(int r=2;r<16;++r)sacc+=pB0[r]; _Pragma("unroll") for(int r=0;r<16;++r)sacc+=pB1[r]; l_reg+=sacc;
    pw0=(u32x4){PKW(pB0,0),PKW(pB0,2),PKW(pB0,4),PKW(pB0,6)};pw1=(u32x4){PKW(pB0,8),PKW(pB0,10),PKW(pB0,12),PKW(pB0,14)};pw2=(u32x4){PKW(pB1,0),PKW(pB1,2),PKW(pB1,4),PKW(pB1,6)};pw3=(u32x4){PKW(pB1,8),PKW(pB1,10),PKW(pB1,12),PKW(pB1,14)};
    SBAR(); pv(o,vb0+sl_cur,PAF(0),PAF(1),PAF(2),PAF(3)); }
  #undef PKW
  #undef PAF
  #undef VFR
  #undef PIN
  #undef MX3
  #undef GAPA
  #undef GAPB
  #undef EX
  #undef VRD
  #undef KRD
  #undef STEP
  #undef ENDW
  {auto rr=__builtin_amdgcn_permlane32_swap(__float_as_uint(l_reg),__float_as_uint(l_reg),false,false);l_reg=__uint_as_float(rr[0])+__uint_as_float(rr[1]);}
  if(hi==0)wsf[32+r32]=l_reg;asm volatile("s_waitcnt lgkmcnt(0)":::"memory");
  float rli[16];
  #pragma unroll
  for(int r=0;r<16;++r)rli[r]=__builtin_amdgcn_rcpf(wsf[32+crow(r,hi)]);
  bf16*Ow=O+(rowbase+q0+wid*QBLK)*DMA+h*D;
  { bf16*stg=(bf16*)(shm+LDS_OST)+wid*2048;
    #pragma unroll
    for(int r=0;r<16;++r){const int orow=crow(r,hi);
      #pragma unroll
      for(int d0=0;d0<2;++d0)stg[orow*64+d0*32+r32]=__float2bfloat16(o[d0][r]*rli[r]);}
    asm volatile("s_waitcnt lgkmcnt(0)":::"memory");
    #pragma unroll
    for(int i=0;i<4;++i){const int row=i*8+(lane>>3),ch=lane&7; const u32x4 v=*(const u32x4*)(stg+row*64+ch*8); ATTN_STORE16(Ow+(long)row*DMA+ch*8,v);} }
  asm volatile("s_waitcnt lgkmcnt(0)\n\ts_barrier":::"memory");
  #undef DMA_K
  #undef DMA_V
  #undef CMASK
  #undef START
  #undef RESC
  #undef ROT
}
#undef SBAR
#undef WAIT_BAR
}

constexpr size_t MiB = 1u << 20;
constexpr size_t WS_CTL = 0, CTL_ZERO_BYTES = 1 * MiB;
constexpr size_t WS_PART = 1 * MiB;
constexpr size_t WS_SKIN = 3 * MiB;
constexpr size_t WS_WSK  = 5 * MiB;
constexpr size_t WS_WIN = 8 * MiB, WS_WOUT = 20 * MiB, WS_WGU = 24 * MiB, WS_WDOWN = 68 * MiB, WS_WKVQ = 90 * MiB, WS_WQ3 = 96 * MiB, WS_WO = 98 * MiB;
constexpr size_t WS_HB = 104 * MiB;
constexpr size_t WS_BIG = 168 * MiB;
constexpr size_t WS_PROJ = WS_BIG;
constexpr size_t WS_OA = WS_BIG + 192 * MiB;
constexpr size_t WS_ACT_GLA = WS_BIG;
constexpr size_t WS_QO = WS_BIG;
constexpr size_t WS_ACT_FOX = WS_BIG;
constexpr size_t WS_HL = 448 * MiB;
constexpr size_t WS_END = 512 * MiB;
static_assert(WS_OA + 64 * MiB <= WS_HL && WS_ACT_FOX + 176 * MiB <= WS_HL && WS_HL + 64 * MiB <= WS_END, "workspace map");
constexpr int CW_BAR = 4096;

constexpr int NWAVES = 8;
constexpr int RING_OFF = 0, RING_BYTES = 131072;
constexpr int LDSCTL_OFF = RING_BYTES, MISC_OFF = LDSCTL_OFF + 320;
constexpr int LDS_BYTES = 147456;

#define GAS __attribute__((address_space(1)))
#define LAS __attribute__((address_space(3)))
typedef unsigned short bf16;
typedef unsigned v4u __attribute__((ext_vector_type(4)));
typedef unsigned v2u __attribute__((ext_vector_type(2)));
typedef float f32x4 __attribute__((ext_vector_type(4)));
typedef float f32x2 __attribute__((ext_vector_type(2)));
typedef short bf16x8 __attribute__((ext_vector_type(8)));
typedef GAS unsigned gu32;
#define RLX_AGENT __ATOMIC_RELAXED, __HIP_MEMORY_SCOPE_AGENT
#define LDS_WAIT() asm volatile("s_waitcnt lgkmcnt(0)" ::: "memory")
#define VM_WAIT() asm volatile("s_waitcnt vmcnt(0)" ::: "memory")
__device__ __forceinline__ unsigned f2bf(float f) { unsigned u = __builtin_bit_cast(unsigned, f); return (u + 0x7fffu + ((u >> 16) & 1u)) >> 16; }
__device__ __forceinline__ unsigned pk2(float lo, float hi) { return f2bf(lo) | (f2bf(hi) << 16); }
__device__ __forceinline__ float bf2f(unsigned short b) { return __builtin_bit_cast(float, (unsigned)b << 16); }
__device__ __forceinline__ float log_sigmoid_f(float x) { return fminf(x, 0.f) - log1pf(expf(-fabsf(x))); }

#define XB_TMO      128
#define XB_XCNT(j)  (256  + 64 * (j))
#define XB_XSUB(j)  (1280 + 64 * (j))
#define XB_XGEN(j)  (2304 + 64 * (j))
#define XB_TOP      3328
#define XB_TOPGEN   3392
#define XCD_BAR_WORDS 3456
#define XB_SPIN_CAP (1u << 18)
__device__ __forceinline__ unsigned xb_ld(unsigned* p)              { return __hip_atomic_load(p, __ATOMIC_RELAXED, __HIP_MEMORY_SCOPE_AGENT); }
__device__ __forceinline__ unsigned xb_add(unsigned* p, unsigned v) { return __hip_atomic_fetch_add(p, v, __ATOMIC_RELAXED, __HIP_MEMORY_SCOPE_AGENT); }
__device__ __forceinline__ unsigned xb_xcc_id() { return (unsigned)__builtin_amdgcn_s_getreg((3 << 11) | 20) & 0xFu; }
#define XB_SPIN(cond, bar) do { unsigned _sp = 0; while (cond) { __builtin_amdgcn_s_sleep(1); \
    if ((++_sp & 255u) == 0u) { if (xb_ld(&(bar)[XB_TMO])) break; if (_sp > XB_SPIN_CAP) { atomicAdd(&(bar)[XB_TMO], 1u); break; } } } } while (0)
struct XcdBarrier { unsigned* bar; unsigned x; volatile LAS unsigned* st; };
__device__ __forceinline__ XcdBarrier xcd_barrier_post(unsigned* bar, volatile LAS unsigned* st) {
    XcdBarrier b; b.bar = bar; b.x = xb_xcc_id(); b.st = st;
    if (threadIdx.x == 0) (void)xb_add(&bar[XB_XCNT(b.x)], 1u);
    return b;
}
__device__ __forceinline__ void xcd_barrier_complete(unsigned* bar, unsigned x, unsigned& nloc, unsigned& nx) {
    const unsigned G = gridDim.x * gridDim.y * gridDim.z;
    unsigned sum, cnt, mine, sp = 0u;
    for (;;) {
        sum = 0u; cnt = 0u; mine = 0u;
#pragma unroll
        for (unsigned j = 0; j < 16; ++j) { const unsigned c = xb_ld(&bar[XB_XCNT(j)]); sum += c; cnt += (c > 0u) ? 1u : 0u; mine = (j == x) ? c : mine; }
        if (sum == G) break;
        __builtin_amdgcn_s_sleep(1);
        if ((++sp & 255u) == 0u) { if (xb_ld(&bar[XB_TMO])) break; if (sp > XB_SPIN_CAP) { atomicAdd(&bar[XB_TMO], 1u); break; } }
    }
    nloc = mine > 0u ? mine : 1u; nx = cnt > 0u ? cnt : 1u;
}
__device__ __forceinline__ void xcd_barrier(const XcdBarrier& b) {
    asm volatile("s_waitcnt vmcnt(0)" ::: "memory");
    __syncthreads();
    if (threadIdx.x == 0) {
        unsigned* bar = b.bar;
        __builtin_amdgcn_s_waitcnt(0);
        unsigned nloc = b.st[0], nx = b.st[1];
        if (nloc == 0u) { xcd_barrier_complete(bar, b.x, nloc, nx); b.st[0] = nloc; b.st[1] = nx; }
        const unsigned old = xb_add(&bar[XB_XSUB(b.x)], 1u);
        const unsigned gen = old / nloc;
        if (old + 1u == (gen + 1u) * nloc) {
            __builtin_amdgcn_fence(__ATOMIC_RELEASE, "agent");
            asm volatile("s_waitcnt vmcnt(0)" ::: "memory");
            const unsigned og = xb_add(&bar[XB_TOP], 1u);
            const unsigned tg = og / nx;
            if (og + 1u == (tg + 1u) * nx) xb_add(&bar[XB_TOPGEN], 1u);
            else XB_SPIN(xb_ld(&bar[XB_TOPGEN]) == tg, bar);
            __builtin_amdgcn_fence(__ATOMIC_ACQUIRE, "agent");
            xb_add(&bar[XB_XGEN(b.x)], 1u);
            asm volatile("s_waitcnt vmcnt(0)" ::: "memory");
        } else {
            XB_SPIN(xb_ld(&bar[XB_XGEN(b.x)]) == gen, bar);
            __builtin_amdgcn_fence(__ATOMIC_ACQUIRE, "agent");
            asm volatile("s_waitcnt vmcnt(0)" ::: "memory");
        }
    }
    __syncthreads();
}

struct Frame {
    LAS unsigned char* lds;
    volatile LAS unsigned* MISC;
    gu32* ctl;
    int tid, lane, wave;
    int vcu, G;
};
__device__ __forceinline__ float wave_sum(float v) {
#pragma unroll
    for (int o = 1; o < 64; o <<= 1) v += __shfl_xor(v, o);
    return v;
}

__device__ __forceinline__ void p0_transpose_item(const float* W, int ldw, int c0, int ncols, int K, const float* gain, float scale, int scale_cols, bf16* WT, int mode, LAS float* scr, int item, int lane) {
    const int nblk = ncols / 32, kb = item / nblk, nb = item % nblk, k0 = 64 * kb, n0 = 32 * nb;
#pragma unroll 8
    for (int i = 0; i < 32; ++i) { const int kk = 2 * i + (lane >> 5); const float gk = gain ? gain[k0 + kk] : 1.0f; scr[kk * 33 + (lane & 31)] = W[(size_t)(k0 + kk) * ldw + c0 + n0 + (lane & 31)] * gk; }
    LDS_WAIT(); asm volatile("" ::: "memory");
    const float sc = (n0 < scale_cols) ? scale : 1.0f;
    const int c = lane & 7;
#pragma unroll
    for (int j = 0; j < 4; ++j) { const int n = (lane >> 3) + 8 * j; const LAS float* s = scr + (8 * c) * 33 + n;
        v4u o; o.x = pk2(s[0 * 33] * sc, s[1 * 33] * sc); o.y = pk2(s[2 * 33] * sc, s[3 * 33] * sc); o.z = pk2(s[4 * 33] * sc, s[5 * 33] * sc); o.w = pk2(s[6 * 33] * sc, s[7 * 33] * sc);
        const int nn = n0 + n; int row = nn;
        if (mode == 1) { row = (nn < DFF) ? (256 * (nn / 128) + (nn % 128)) : (256 * ((nn - DFF) / 128) + 128 + ((nn - DFF) % 128)); }
        *(GAS v4u*)(WT + (size_t)row * K + k0 + 8 * c) = o; }
    LDS_WAIT(); asm volatile("" ::: "memory");
}

struct Args { const float* in[16]; float* out; unsigned char* ws; int lo, hi; };

__device__ __forceinline__ void skinny_phase(const Frame& F, const bf16* hb, const bf16* Wt, const float* part, float* out) {
    int tid_ = threadIdx.x; asm volatile("" : "+v"(tid_)); const int lane_ = tid_ & 63, wave_ = __builtin_amdgcn_readfirstlane(tid_ >> 6);
    const int gw = F.vcu * NWAVES + wave_, NGW = F.G * NWAVES, fr = lane_ & 15, fq = lane_ >> 4;
    for (int tile = gw; tile < MTOK / 16; tile += NGW) {
        const int row0 = tile * 16;
        const bf16* ap = hb + (size_t)(row0 + fr) * DM + fq * 8; const bf16* bp = Wt + (size_t)fr * DM + fq * 8;
        f32x4 acc = (f32x4){0.f, 0.f, 0.f, 0.f};
#pragma unroll 8
        for (int ks = 0; ks < DM / 32; ++ks) { const bf16x8 a = *(const bf16x8*)(ap + 32 * ks), b = *(const bf16x8*)(bp + 32 * ks); acc = __builtin_amdgcn_mfma_f32_16x16x32_bf16(a, b, acc, 0, 0, 0); }
#pragma unroll
        for (int r = 0; r < 4; ++r) { const int row = row0 + 4 * fq + r; out[(size_t)row * 16 + fr] = acc[r] * pg8::rstd_row(part, row); }
    }
}

__device__ __forceinline__ void gate_phase(const Frame& F, const bf16* oa, bf16* oa_out, const bf16* proj, const float* ghead) {
    int tid_ = threadIdx.x; asm volatile("" : "+v"(tid_)); const int lane_ = tid_ & 63, wave_ = __builtin_amdgcn_readfirstlane(tid_ >> 6);
    const int gw = F.vcu * NWAVES + wave_, NGW = F.G * NWAVES;
    for (int m = gw; m < MTOK; m += NGW) {
#pragma unroll
        for (int j = 0; j < 2; ++j) {
            const int col = lane_ * 8 + 512 * j;
            const v4u ov = *(const GAS v4u*)(oa + (size_t)m * GV + col); const v4u rv = *(const GAS v4u*)(proj + (size_t)m * GPROJ + 2048 + col);
            float o[8], r[8];
#pragma unroll
            for (int i = 0; i < 4; ++i) { o[2 * i] = __builtin_bit_cast(float, ov[i] << 16); o[2 * i + 1] = __builtin_bit_cast(float, ov[i] & 0xffff0000u); r[2 * i] = __builtin_bit_cast(float, rv[i] << 16); r[2 * i + 1] = __builtin_bit_cast(float, rv[i] & 0xffff0000u); }
            float ss = 0.f;
#pragma unroll
            for (int i = 0; i < 8; ++i) ss += o[i] * o[i];
#pragma unroll
            for (int s = 1; s < 32; s <<= 1) ss += __shfl_xor(ss, s);
            const float rs = 1.0f / sqrtf(ss * (1.0f / 256.0f) + EPS);
            const f32x4 g0 = *(const GAS f32x4*)(ghead + (col & 255)), g1 = *(const GAS f32x4*)(ghead + (col & 255) + 4);
            float a[8];
#pragma unroll
            for (int i = 0; i < 8; ++i) { const float g = i < 4 ? g0[i] : g1[i - 4]; a[i] = o[i] * rs * g * pg8::silu_f(r[i]); }
            v4u w; w.x = pk2(a[0], a[1]); w.y = pk2(a[2], a[3]); w.z = pk2(a[4], a[5]); w.w = pk2(a[6], a[7]);
            *(GAS v4u*)(oa_out + (size_t)m * GV + col) = w;
        }
    }
}

__device__ __forceinline__ void final_phase(const Frame& F, float* out, const bf16* hi, const bf16* lo, const float* part, const float* g) {
    int tid_ = threadIdx.x; asm volatile("" : "+v"(tid_)); const int lane_ = tid_ & 63, wave_ = __builtin_amdgcn_readfirstlane(tid_ >> 6);
    const int gw = F.vcu * NWAVES + wave_, NGW = F.G * NWAVES;
    for (int m = gw; m < MTOK; m += NGW) {
        const float rs = pg8::rstd_row(part, m);
#pragma unroll
        for (int j = 0; j < 2; ++j) {
            const int col = lane_ * 8 + 512 * j;
            const v4u a = *(const GAS v4u*)(hi + (size_t)m * DM + col), b = *(const GAS v4u*)(lo + (size_t)m * DM + col);
            const f32x4 g0 = *(const GAS f32x4*)(g + col), g1 = *(const GAS f32x4*)(g + col + 4);
            f32x4 o0, o1;
#pragma unroll
            for (int i = 0; i < 2; ++i) {
                o0[2 * i] = (__builtin_bit_cast(float, a[i] << 16) + __builtin_bit_cast(float, b[i] << 16)) * rs * g0[2 * i];
                o0[2 * i + 1] = (__builtin_bit_cast(float, a[i] & 0xffff0000u) + __builtin_bit_cast(float, b[i] & 0xffff0000u)) * rs * g0[2 * i + 1];
                o1[2 * i] = (__builtin_bit_cast(float, a[2 + i] << 16) + __builtin_bit_cast(float, b[2 + i] << 16)) * rs * g1[2 * i];
                o1[2 * i + 1] = (__builtin_bit_cast(float, a[2 + i] & 0xffff0000u) + __builtin_bit_cast(float, b[2 + i] & 0xffff0000u)) * rs * g1[2 * i + 1]; }
            *(GAS f32x4*)(out + (size_t)m * DM + col) = o0; *(GAS f32x4*)(out + (size_t)m * DM + col + 4) = o1;
        }
    }
}

namespace gla {
constexpr int QD_OFF = 0, KD_OFF = 17408, KE_OFF = 34816, VT_OFF = 53248, AM_OFF = 62464, ST_OFF = 71680, AL_OFF = 89088, SEG_OFF = 93184, DEC_OFF = 97280, LDS_END = 97792;
constexpr int SW = 272, SN = 144;
static_assert(LDS_END <= RING_BYTES, "scan LDS map");
}
__device__ __forceinline__ void scan_phase(const Frame& F, const bf16* proj, const float* alow, const float* Wup, const float* balpha, bf16* oa) {
    using namespace gla;
#define SCAN_SYNC() do { asm volatile("s_waitcnt lgkmcnt(0)" ::: "memory"); __builtin_amdgcn_s_barrier(); asm volatile("" ::: "memory"); } while (0)
    typedef LAS const bf16x8* lfrag;
    int tid_ = threadIdx.x; asm volatile("" : "+v"(tid_));
    const int tid = tid_, lane = tid & 63, wave = __builtin_amdgcn_readfirstlane(tid >> 6), fr = lane & 15, fq = lane >> 4;
    LAS unsigned char* L = F.lds + RING_OFF;
    for (int unit = F.vcu; unit < BATCH * GH * 4; unit += F.G) {
        const int bh = unit >> 2, sl = unit & 3, b = bh >> 2, h = bh & 3;
        const size_t row0 = (size_t)b * SEQ;
        const int d0 = 2 * lane;
        float wu0[16], wu1[16];
#pragma unroll
        for (int j = 0; j < 16; ++j) { const f32x2 w2 = *(const f32x2*)(Wup + j * GQK + h * GDK + d0); wu0[j] = w2.x; wu1[j] = w2.y; }
        const f32x2 ba2 = *(const f32x2*)(balpha + h * GDK + d0);
        f32x4 S[4];
#pragma unroll
        for (int i = 0; i < 4; ++i) S[i] = (f32x4){0.f, 0.f, 0.f, 0.f};
        for (int i = tid; i < (64 * SW) / 4; i += NWAVES * 64) ((LAS unsigned*)(L + ST_OFF))[i] = 0u;
        const bf16* qbase = proj + (row0 + 8 * wave) * GPROJ + h * GDK + d0;
        const bf16* vbase = proj + (row0 + 8 * wave) * GPROJ + 2 * GQK + h * GDV + 64 * sl + lane;
        const float* abase = alow + (row0 + (tid >> 2)) * 16 + 4 * (tid & 3);
        unsigned qreg[8], kreg[8], vreg[8]; f32x4 alreg = (f32x4){0.f, 0.f, 0.f, 0.f};
#define GLA_LOAD(n) do { _Pragma("unroll") for (int i = 0; i < 8; ++i) { const size_t ro = ((size_t)(n) * 64 + i) * GPROJ; qreg[i] = *(const unsigned*)(qbase + ro); kreg[i] = *(const unsigned*)(qbase + ro + GQK); vreg[i] = (unsigned)vbase[ro]; } \
        if (tid < 256) alreg = *(const f32x4*)(abase + (size_t)(n) * 64 * 16); } while (0)
        GLA_LOAD(0);
        if (tid < 256) *(LAS f32x4*)(L + AL_OFF + tid * 16) = alreg;
        SCAN_SYNC();
        for (int n = 0; n < SEQ / 64; ++n) {
            float loc0[8], loc1[8]; float run0 = 0.f, run1 = 0.f;
#pragma unroll
            for (int i = 0; i < 8; ++i) {
                const LAS f32x4* ap = (const LAS f32x4*)(L + AL_OFF + (8 * wave + i) * 64);
                float z0 = ba2.x, z1 = ba2.y;
#pragma unroll
                for (int j4 = 0; j4 < 4; ++j4) { const f32x4 a = ap[j4];
#pragma unroll
                    for (int e = 0; e < 4; ++e) { z0 += a[e] * wu0[4 * j4 + e]; z1 += a[e] * wu1[4 * j4 + e]; } }
                const float l0 = (fminf(z0, 0.f) - 0.6931471805599453f * __builtin_amdgcn_logf(1.0f + __builtin_amdgcn_exp2f(-fabsf(z0) * LOG2E))) * 0.0625f;
                const float l1 = (fminf(z1, 0.f) - 0.6931471805599453f * __builtin_amdgcn_logf(1.0f + __builtin_amdgcn_exp2f(-fabsf(z1) * LOG2E))) * 0.0625f;
                run0 += l0; run1 += l1; loc0[i] = run0; loc1[i] = run1;
            }
            *(LAS f32x2*)(L + SEG_OFF + (wave * 128 + d0) * 4) = (f32x2){run0, run1};
            SCAN_SYNC();
#pragma unroll
            for (int i = 0; i < 8; ++i) asm volatile("" : "+v"(qreg[i]), "+v"(kreg[i]), "+v"(vreg[i]));
            float off0 = 0.f, off1 = 0.f, tot0 = 0.f, tot1 = 0.f;
#pragma unroll
            for (int w = 0; w < 8; ++w) { const f32x2 t2 = *(const LAS f32x2*)(L + SEG_OFF + (w * 128 + d0) * 4); if (w < wave) { off0 += t2.x; off1 += t2.y; } tot0 += t2.x; tot1 += t2.y; }
            const float edl0 = __builtin_amdgcn_exp2f(tot0 * LOG2E), edl1 = __builtin_amdgcn_exp2f(tot1 * LOG2E);
            unsigned ke0[4], ke1[4];
#pragma unroll
            for (int i = 0; i < 8; i += 2) {
                float kev0[2], kev1[2];
#pragma unroll
                for (int u = 0; u < 2; ++u) {
                    const float b0 = (off0 + loc0[i + u]) * LOG2E, b1 = (off1 + loc1[i + u]) * LOG2E;
                    const float eb0 = __builtin_amdgcn_exp2f(b0), eb1 = __builtin_amdgcn_exp2f(b1), en0 = __builtin_amdgcn_exp2f(-b0), en1 = __builtin_amdgcn_exp2f(-b1);
                    const float q0 = __builtin_bit_cast(float, qreg[i + u] << 16), q1 = __builtin_bit_cast(float, qreg[i + u] & 0xffff0000u);
                    const float k0 = __builtin_bit_cast(float, kreg[i + u] << 16), k1 = __builtin_bit_cast(float, kreg[i + u] & 0xffff0000u);
                    const int c = 8 * wave + i + u;
                    *(LAS unsigned*)(L + QD_OFF + c * SW + 2 * d0) = pg8::cvt_pk_bf16(q0 * eb0, q1 * eb1);
                    *(LAS unsigned*)(L + KD_OFF + c * SW + 2 * d0) = pg8::cvt_pk_bf16(k0 * en0, k1 * en1);
                    kev0[u] = k0 * en0 * edl0; kev1[u] = k1 * en1 * edl1;
                }
                ke0[i >> 1] = pg8::cvt_pk_bf16(kev0[0], kev0[1]); ke1[i >> 1] = pg8::cvt_pk_bf16(kev1[0], kev1[1]);
            }
            *(LAS v4u*)(L + KE_OFF + d0 * SN + 16 * wave) = (v4u){ke0[0], ke0[1], ke0[2], ke0[3]};
            *(LAS v4u*)(L + KE_OFF + (d0 + 1) * SN + 16 * wave) = (v4u){ke1[0], ke1[1], ke1[2], ke1[3]};
            if (wave == 0) *(LAS f32x2*)(L + DEC_OFF + d0 * 4) = (f32x2){edl0, edl1};
            { v4u vv; vv.x = vreg[0] | (vreg[1] << 16); vv.y = vreg[2] | (vreg[3] << 16); vv.z = vreg[4] | (vreg[5] << 16); vv.w = vreg[6] | (vreg[7] << 16);
              *(LAS v4u*)(L + VT_OFF + lane * SN + 16 * wave) = vv; }
            if (n + 1 < SEQ / 64) GLA_LOAD(n + 1);
            SCAN_SYNC();
            {
                const int ci = wave >> 1, sh = wave & 1;
#pragma unroll
                for (int tt = 0; tt < 2; ++tt) {
                    const int si = 2 * sh + tt; f32x4 acc = (f32x4){0.f, 0.f, 0.f, 0.f};
                    if (si <= ci) {
#pragma unroll
                        for (int ks = 0; ks < 4; ++ks) { const bf16x8 a = *(lfrag)(L + QD_OFF + (16 * ci + fr) * SW + (32 * ks + 8 * fq) * 2), bb = *(lfrag)(L + KD_OFF + (16 * si + fr) * SW + (32 * ks + 8 * fq) * 2);
                            acc = __builtin_amdgcn_mfma_f32_16x16x32_bf16(a, bb, acc, 0, 0, 0); }
                    }
#pragma unroll
                    for (int r = 0; r < 4; ++r) { const int c = 16 * ci + 4 * fq + r, sx = 16 * si + fr; const float v = (sx <= c) ? acc[r] : 0.f;
                        *(LAS unsigned short*)(L + AM_OFF + c * SN + 2 * sx) = (unsigned short)f2bf(v); }
                }
            }
            {
                const f32x4 dec = *(const LAS f32x4*)(L + DEC_OFF + (16 * wave + 4 * fq) * 4);
#pragma unroll
                for (int vi = 0; vi < 4; ++vi) S[vi] = S[vi] * dec;
#pragma unroll
                for (int ks = 0; ks < 2; ++ks) { const bf16x8 a = *(lfrag)(L + KE_OFF + (16 * wave + fr) * SN + (32 * ks + 8 * fq) * 2);
#pragma unroll
                    for (int vi = 0; vi < 4; ++vi) { const bf16x8 bb = *(lfrag)(L + VT_OFF + (16 * vi + fr) * SN + (32 * ks + 8 * fq) * 2); S[vi] = __builtin_amdgcn_mfma_f32_16x16x32_bf16(a, bb, S[vi], 0, 0, 0); } }
            }
            SCAN_SYNC();
            {
                const int ci = wave >> 1, vh = wave & 1; f32x4 o0 = (f32x4){0.f, 0.f, 0.f, 0.f}, o1 = o0;
#pragma unroll
                for (int ks = 0; ks < 2; ++ks) { if (ks == 1 && ci < 2) continue;
                    const bf16x8 a = *(lfrag)(L + AM_OFF + (16 * ci + fr) * SN + (32 * ks + 8 * fq) * 2);
                    const bf16x8 b0 = *(lfrag)(L + VT_OFF + (32 * vh + fr) * SN + (32 * ks + 8 * fq) * 2), b1 = *(lfrag)(L + VT_OFF + (32 * vh + 16 + fr) * SN + (32 * ks + 8 * fq) * 2);
                    o0 = __builtin_amdgcn_mfma_f32_16x16x32_bf16(a, b0, o0, 0, 0, 0); o1 = __builtin_amdgcn_mfma_f32_16x16x32_bf16(a, b1, o1, 0, 0, 0); }
#pragma unroll
                for (int ks = 0; ks < 4; ++ks) {
                    const bf16x8 a = *(lfrag)(L + QD_OFF + (16 * ci + fr) * SW + (32 * ks + 8 * fq) * 2);
                    const bf16x8 b0 = *(lfrag)(L + ST_OFF + (32 * vh + fr) * SW + (32 * ks + 8 * fq) * 2), b1 = *(lfrag)(L + ST_OFF + (32 * vh + 16 + fr) * SW + (32 * ks + 8 * fq) * 2);
                    o0 = __builtin_amdgcn_mfma_f32_16x16x32_bf16(a, b0, o0, 0, 0, 0); o1 = __builtin_amdgcn_mfma_f32_16x16x32_bf16(a, b1, o1, 0, 0, 0); }
                bf16* op = oa + (row0 + (size_t)n * 64 + 16 * ci + 4 * fq) * GV + h * GDV + 64 * sl + 32 * vh + fr;
#pragma unroll
                for (int r = 0; r < 4; ++r) { op[(size_t)r * GV] = (bf16)f2bf(o0[r]); op[(size_t)r * GV + 16] = (bf16)f2bf(o1[r]); }
            }
            if (tid < 256 && n + 1 < SEQ / 64) *(LAS f32x4*)(L + AL_OFF + tid * 16) = alreg;
            SCAN_SYNC();
#pragma unroll
            for (int vi = 0; vi < 4; ++vi) { v2u w; w.x = pg8::cvt_pk_bf16(S[vi][0], S[vi][1]); w.y = pg8::cvt_pk_bf16(S[vi][2], S[vi][3]);
                *(LAS v2u*)(L + ST_OFF + (16 * vi + fr) * SW + (16 * wave + 4 * fq) * 2) = w; }
        }
#undef GLA_LOAD
        SCAN_SYNC();
    }
#undef SCAN_SYNC
}

__device__ __forceinline__ void attn_phase(const Frame& F, unsigned char* lds_generic, const float* flog, const float* b_f, const bf16* Q, const bf16* K, const bf16* V, bf16* O) {
    for (int bh = F.vcu; bh < BATCH * FH; bh += F.G) {
        const int b = bh / FH, h = bh % FH;
        LAS float* bt = (LAS float*)(F.lds + RING_OFF + attn_body::LDS_BIAS); LAS float* wt = (LAS float*)(F.lds + RING_OFF + attn_body::LDS_SCAN);
        const float bf = b_f[h];
        float ls[4]; float run = 0.f;
#pragma unroll
        for (int i = 0; i < 4; ++i) { const float x = flog[((size_t)b * SEQ + 4 * F.tid + i) * 16 + h] + bf; run += log_sigmoid_f(x); ls[i] = run; }
        float incl = run;
#pragma unroll
        for (int o = 1; o < 64; o <<= 1) { const float y = __shfl_up(incl, o); if (F.lane >= o) incl += y; }
        if (F.lane == 63) wt[F.wave] = incl;
        LDS_WAIT(); __syncthreads();
        float off = 0.f;
        for (int w = 0; w < F.wave; ++w) off += wt[w];
        const float excl = off + incl - run;
#pragma unroll
        for (int i = 0; i < 4; ++i) bt[4 * F.tid + i] = -(excl + ls[i]) * LOG2E;
        LDS_WAIT(); __syncthreads();
        for (int i = 0; i < attn_body::NQB; ++i)
            attn_body::attn_unit<8>(b, h, attn_body::NQB - 1 - i, (const attn_body::bf16*)Q, (const attn_body::bf16*)K, (const attn_body::bf16*)V, (attn_body::bf16*)O, (char*)lds_generic + RING_OFF);
        __syncthreads();
    }
}

__global__ void __launch_bounds__(NWAVES * 64, 2) yoco_fwd(Args args) {
    extern __shared__ __attribute__((aligned(16))) unsigned char lds[];
    Frame F;
    F.lds = (LAS unsigned char*)lds;
    F.MISC = (volatile LAS unsigned*)(F.lds + MISC_OFF);
    F.tid = threadIdx.x; F.lane = F.tid & 63; F.wave = __builtin_amdgcn_readfirstlane(F.tid >> 6);
    F.G = gridDim.x; { const int bx = blockIdx.x; F.vcu = (F.G % 8 == 0) ? (bx % 8) * (F.G / 8) + bx / 8 : bx; }
    unsigned char* ws = args.ws;
    F.ctl = (gu32*)(ws + WS_CTL);
    const int lo = args.lo, hi = args.hi;
    for (int u = F.tid; u < (LDS_BYTES - LDSCTL_OFF) / 4; u += NWAVES * 64) ((LAS unsigned*)(F.lds + LDSCTL_OFF))[u] = 0u;
    __syncthreads();
    XcdBarrier bar; bar.bar = (unsigned*)(F.ctl + CW_BAR); bar.x = 0; bar.st = nullptr;
    if (hi - lo > 1) bar = xcd_barrier_post((unsigned*)(F.ctl + CW_BAR), F.MISC + 8);
#define ON(s) (lo <= (s) && (s) < hi)
#define SEAM(s) do { if (lo <= (s) && (s) + 1 < hi) xcd_barrier(bar); } while (0)

    const float* x = args.in[0]; const float* attn_norm = args.in[1]; const float* ffn_norm = args.in[2]; const float* gla_w_in = args.in[3];
    const float* gla_g_head = args.in[6]; const float* gla_w_out = args.in[7];
    const float* kv_norm = args.in[8]; const float* w_kv = args.in[9]; const float* b_f = args.in[10]; const float* fox_w_q = args.in[11]; const float* fox_w_o = args.in[12];
    const float* ffn_w_gu = args.in[13]; const float* ffn_w_down = args.in[14]; const float* final_norm = args.in[15];
    float* out = args.out;
    float* part = (float*)(ws + WS_PART); float* skin = (float*)(ws + WS_SKIN); bf16* wsk = (bf16*)(ws + WS_WSK);
    bf16* Win_t = (bf16*)(ws + WS_WIN); bf16* Wout_t = (bf16*)(ws + WS_WOUT); bf16* Wgu_t = (bf16*)(ws + WS_WGU); bf16* Wdown_t = (bf16*)(ws + WS_WDOWN);
    bf16* Wkvq_t = (bf16*)(ws + WS_WKVQ); bf16* Wq3_t = (bf16*)(ws + WS_WQ3); bf16* Wo_t = (bf16*)(ws + WS_WO);
    bf16* hb = (bf16*)(ws + WS_HB); bf16* proj = (bf16*)(ws + WS_PROJ); bf16* oa = (bf16*)(ws + WS_OA);
    bf16* Kb = (bf16*)out; bf16* Vb = (bf16*)out + (size_t)MTOK * DM; bf16* QO = (bf16*)(ws + WS_QO); bf16* hl = (bf16*)(ws + WS_HL);

    if (ON(0)) for (int rep_ = 0; rep_ < (PROBE_STEP == 0 ? 2 : 1); ++rep_) {
        if (rep_) xcd_barrier(bar);
        LAS float* scr = (LAS float*)(F.lds + RING_OFF + F.wave * 16384);
        const int gw = F.vcu * NWAVES + F.wave, NGW = F.G * NWAVES;
        constexpr int I_IN = (DM / 64) * (GPROJ / 32), I_SQ = (DM / 64) * (DM / 32), I_GU = (DM / 64) * (NGU / 32), I_DN = (DFF / 64) * (DM / 32), I_KV = (DM / 64) * (2048 / 32);
        constexpr int NITEMS = 2 * I_IN + 2 * I_SQ + 4 * I_GU + 4 * I_DN + I_KV + 2 * I_SQ + 2 * I_SQ;
        for (int it = gw; it < NITEMS; it += NGW) {
            int r = it;
            if (r < 2 * I_IN) { const int l = r / I_IN; r -= l * I_IN; p0_transpose_item(gla_w_in + (size_t)l * DM * GIN, GIN, 0, GPROJ, DM, attn_norm + l * DM, QSCALE_GLA, GQK, Win_t + (size_t)l * GPROJ * DM, 0, scr, r, F.lane); continue; } r -= 2 * I_IN;
            if (r < 2 * I_SQ) { const int l = r / I_SQ; r -= l * I_SQ; p0_transpose_item(gla_w_out + (size_t)l * DM * DM, DM, 0, DM, DM, nullptr, 1.f, 0, Wout_t + (size_t)l * DM * DM, 0, scr, r, F.lane); continue; } r -= 2 * I_SQ;
            if (r < 4 * I_GU) { const int l = r / I_GU; r -= l * I_GU; p0_transpose_item(ffn_w_gu + (size_t)l * DM * NGU, NGU, 0, NGU, DM, ffn_norm + l * DM, 1.f, 0, Wgu_t + (size_t)l * NGU * DM, 1, scr, r, F.lane); continue; } r -= 4 * I_GU;
            if (r < 4 * I_DN) { const int l = r / I_DN; r -= l * I_DN; p0_transpose_item(ffn_w_down + (size_t)l * DFF * DM, DM, 0, DM, DFF, nullptr, 1.f, 0, Wdown_t + (size_t)l * DM * DFF, 0, scr, r, F.lane); continue; } r -= 4 * I_DN;
            if (r < I_KV) { p0_transpose_item(w_kv, KVOUT, 0, 2048, DM, kv_norm, 1.f, 0, Wkvq_t, 0, scr, r, F.lane); continue; } r -= I_KV;
            if (r < 2 * I_SQ) { const int l = r / I_SQ; r -= l * I_SQ; p0_transpose_item(fox_w_q + (size_t)l * DM * DM, DM, 0, DM, DM, attn_norm + (2 + l) * DM, QSCALE_FOX, DM, l == 0 ? Wkvq_t + (size_t)2048 * DM : Wq3_t, 0, scr, r, F.lane); continue; } r -= 2 * I_SQ;
            { const int l = r / I_SQ; r -= l * I_SQ; p0_transpose_item(fox_w_o + (size_t)l * DM * DM, DM, 0, DM, DM, nullptr, 1.f, 0, Wo_t + (size_t)l * DM * DM, 0, scr, r, F.lane); }
        }
        for (int e = (F.vcu * NWAVES * 64 + F.tid); e < 3 * 16 * DM; e += F.G * NWAVES * 64) {
            const int j = e / (16 * DM), n = (e / DM) % 16, k = e % DM; float v;
            if (j < 2) v = gla_w_in[(size_t)j * DM * GIN + (size_t)k * GIN + GPROJ + n] * attn_norm[j * DM + k]; else v = w_kv[(size_t)k * KVOUT + 2048 + n] * kv_norm[k];
            wsk[e] = (bf16)f2bf(v);
        }
        for (int m = gw; m < MTOK; m += NGW) {
            const GAS f32x4* xr = (const GAS f32x4*)(x + (size_t)m * DM) + F.lane; f32x4 v[4]; float s = 0.f;
#pragma unroll
            for (int j = 0; j < 4; ++j) { v[j] = xr[64 * j]; s += (v[j][0] * v[j][0] + v[j][1] * v[j][1]) + (v[j][2] * v[j][2] + v[j][3] * v[j][3]); }
            s = wave_sum(s);
            GAS v2u* o8 = (GAS v2u*)(hb + (size_t)m * DM) + F.lane;
#pragma unroll
            for (int j = 0; j < 4; ++j) { v2u w; w.x = pk2(v[j][0], v[j][1]); w.y = pk2(v[j][2], v[j][3]); o8[64 * j] = w; }
            if (F.lane < 16) part[(size_t)m * 16 + F.lane] = (F.lane == 0) ? s : 0.f;
        }
    }
    SEAM(0);

    for (int l = 0; l < 2; ++l) {
        const int sb = 1 + 6 * l;
        const float* hin = (l == 0) ? x : nullptr;
        if (ON(sb)) for (int rep_ = 0; rep_ < ((PROBE_STEP == 1 && l == 0) ? 2 : 1); ++rep_) {
            if (rep_) xcd_barrier(bar);
            skinny_phase(F, hb, wsk + (size_t)l * 16 * DM, part, skin);
            pg8::Gemm g{hb, Win_t + (size_t)l * GPROJ * DM, MTOK, GPROJ, DM}; pg8::StaticOrder S; S.init(MTOK, GPROJ, F.G, (int)blockIdx.x);
            pg8::EpiRowScaleBf16 E{proj, GPROJ, part, 0, nullptr, nullptr};
            pg8::gemm_phase<pg8::EpiRowScaleBf16, pg8::StaticOrder, true, true>(F.lds + RING_OFF, g, S, E);
        }
        SEAM(sb);
        if (ON(sb + 1)) for (int rep_ = 0; rep_ < ((PROBE_STEP == 2 && l == 0) ? 2 : 1); ++rep_) {
            if (rep_) xcd_barrier(bar);
            scan_phase(F, proj, skin, args.in[4] + (size_t)l * GRANK * GQK, args.in[5] + (size_t)l * GQK, oa);
        }
        SEAM(sb + 1);
        if (ON(sb + 2)) {
            if (PROBE_STEP == 3 && l == 0) { gate_phase(F, oa, (bf16*)(ws + WS_OA + 64 * MiB), proj, gla_g_head + l * GDV); xcd_barrier(bar); }
            gate_phase(F, oa, oa, proj, gla_g_head + l * GDV);
        }
        SEAM(sb + 2);
        if (ON(sb + 3)) {
            pg8::Gemm g{oa, Wout_t + (size_t)l * DM * DM, MTOK, DM, DM}; pg8::StaticOrder S; S.init(MTOK, DM, F.G, (int)blockIdx.x);
            pg8::EpiResid E{hin, hb, hl, part};
            pg8::gemm_phase<pg8::EpiResid, pg8::StaticOrder, true, true>(F.lds + RING_OFF, g, S, E);
        }
        SEAM(sb + 3);
        bf16* act = (bf16*)(ws + WS_ACT_GLA);
        if (ON(sb + 4)) for (int rep_ = 0; rep_ < ((PROBE_STEP == 5 && l == 0) ? 2 : 1); ++rep_) {
            if (rep_) xcd_barrier(bar);
            pg8::Gemm g{hb, Wgu_t + (size_t)l * NGU * DM, MTOK, NGU, DM}; pg8::StaticOrder S; S.init(MTOK, NGU, F.G, (int)blockIdx.x);
            pg8::EpiSwiglu E{act, DFF, part};
            pg8::gemm_phase<pg8::EpiSwiglu, pg8::StaticOrder, true, true>(F.lds + RING_OFF, g, S, E);
        }
        SEAM(sb + 4);
        if (ON(sb + 5)) {
            pg8::Gemm g{act, Wdown_t + (size_t)l * DM * DFF, MTOK, DM, DFF}; pg8::StaticOrder S; S.init(MTOK, DM, F.G, (int)blockIdx.x);
            pg8::EpiResid E{nullptr, hb, hl, part};
            pg8::gemm_phase<pg8::EpiResid, pg8::StaticOrder, true, true>(F.lds + RING_OFF, g, S, E);
        }
        SEAM(sb + 5);
    }

    for (int j = 0; j < 2; ++j) {
        const int sb = 13 + 5 * j;
        if (ON(sb)) for (int rep_ = 0; rep_ < ((PROBE_STEP == 13 && j == 0) ? 2 : 1); ++rep_) {
            if (rep_) xcd_barrier(bar);
            if (j == 0) {
                skinny_phase(F, hb, wsk + (size_t)2 * 16 * DM, part, skin);
                pg8::Gemm g{hb, Wkvq_t, MTOK, 3 * DM, DM}; pg8::StaticOrder S; S.init(MTOK, 3 * DM, F.G, (int)blockIdx.x);
                pg8::EpiRowScaleBf16 E{Kb, DM, part, DM, Vb, QO};
                pg8::gemm_phase<pg8::EpiRowScaleBf16, pg8::StaticOrder, true, true>(F.lds + RING_OFF, g, S, E);
            } else {
                pg8::Gemm g{hb, Wq3_t, MTOK, DM, DM}; pg8::StaticOrder S; S.init(MTOK, DM, F.G, (int)blockIdx.x);
                pg8::EpiRowScaleBf16 E{QO, DM, part, 0, nullptr, nullptr};
                pg8::gemm_phase<pg8::EpiRowScaleBf16, pg8::StaticOrder, true, true>(F.lds + RING_OFF, g, S, E);
            }
        }
        SEAM(sb);
        if (ON(sb + 1)) {
            if (PROBE_STEP == 14 && j == 0) { attn_phase(F, lds, skin, b_f, QO, Kb, Vb, (bf16*)(ws + WS_QO + 64 * MiB)); xcd_barrier(bar); }
            attn_phase(F, lds, skin, b_f, QO, Kb, Vb, QO);
        }
        SEAM(sb + 1);
        if (ON(sb + 2)) {
            pg8::Gemm g{QO, Wo_t + (size_t)j * DM * DM, MTOK, DM, DM}; pg8::StaticOrder S; S.init(MTOK, DM, F.G, (int)blockIdx.x);
            pg8::EpiResid E{nullptr, hb, hl, part};
            pg8::gemm_phase<pg8::EpiResid, pg8::StaticOrder, true, true>(F.lds + RING_OFF, g, S, E);
        }
        SEAM(sb + 2);
        bf16* act = (bf16*)(ws + WS_ACT_FOX);
        if (ON(sb + 3)) {
            pg8::Gemm g{hb, Wgu_t + (size_t)(2 + j) * NGU * DM, MTOK, NGU, DM}; pg8::StaticOrder S; S.init(MTOK, NGU, F.G, (int)blockIdx.x);
            pg8::EpiSwiglu E{act, DFF, part};
            pg8::gemm_phase<pg8::EpiSwiglu, pg8::StaticOrder, true, true>(F.lds + RING_OFF, g, S, E);
        }
        SEAM(sb + 3);
        if (ON(sb + 4)) {
            pg8::Gemm g{act, Wdown_t + (size_t)(2 + j) * DM * DFF, MTOK, DM, DFF}; pg8::StaticOrder S; S.init(MTOK, DM, F.G, (int)blockIdx.x);
            pg8::EpiResid E{nullptr, hb, hl, part};
            pg8::gemm_phase<pg8::EpiResid, pg8::StaticOrder, true, true>(F.lds + RING_OFF, g, S, E);
        }
        SEAM(sb + 4);
    }
    if (ON(23)) final_phase(F, out, hb, hl, part, final_norm);
#undef ON
#undef SEAM
}

extern "C" void kernel_launch(void* const* d_in, const int* in_sizes, int n_in, void* d_out, int out_size, void* d_ws, size_t ws_size, hipStream_t stream) {
    static int grid = 0;
    if (grid == 0) {
        if (n_in != 16 || out_size != MTOK * DM || ws_size < WS_END) { fprintf(stderr, "kernel_launch: unexpected shapes (n_in %d, out %d, ws %zu)\n", n_in, out_size, ws_size); grid = -1; return; }
        int dev = 0, cus = 0, per_cu = 0;
        if (hipGetDevice(&dev) != hipSuccess || hipDeviceGetAttribute(&cus, hipDeviceAttributeMultiprocessorCount, dev) != hipSuccess) { grid = -1; return; }
        if (hipFuncSetAttribute((const void*)yoco_fwd, hipFuncAttributeMaxDynamicSharedMemorySize, LDS_BYTES) != hipSuccess) { fprintf(stderr, "kernel_launch: hipFuncSetAttribute failed\n"); grid = -1; return; }
        if (hipOccupancyMaxActiveBlocksPerMultiprocessor(&per_cu, (const void*)yoco_fwd, NWAVES * 64, LDS_BYTES) != hipSuccess || per_cu < 1) fprintf(stderr, "kernel_launch: occupancy query reports %d\n", per_cu);
        (void)hipGetLastError();
        grid = cus;
    }
    if (grid < 0) return;
    (void)hipMemsetAsync((char*)d_ws + WS_CTL, 0, CTL_ZERO_BYTES, stream);
    Args a{};
    for (int i = 0; i < 16; ++i) a.in[i] = (const float*)d_in[i];
    a.out = (float*)d_out; a.ws = (unsigned char*)d_ws;
#if KMODE == 1
    a.lo = 0; a.hi = 24;
    hipLaunchKernelGGL(yoco_fwd, dim3(grid), dim3(NWAVES * 64), LDS_BYTES, stream, a);
#else
    for (int s = 0; s < 24; ++s) { a.lo = s; a.hi = s + 1; hipLaunchKernelGGL(yoco_fwd, dim3(grid), dim3(NWAVES * 64), LDS_BYTES, stream, a); }
#endif
}
```

```cpp
#include <hip/hip_runtime.h>
#include <hip/hip_bf16.h>
#include <cstdio>
#include <cstdint>
#include <cmath>

#ifndef KMODE
#define KMODE 1
#endif

constexpr int BATCH = 16, SEQ = 2048, DM = 1024, MTOK = BATCH * SEQ;
constexpr int GH = 4, GDK = 128, GDV = 256, GQK = 512, GV = 1024, GRANK = 16, GIN = 3088, GPROJ = 3072;
constexpr int FH = 16, FHD = 64, KVOUT = 2064;
constexpr int DFF = 2816, NGU = 2 * DFF;
constexpr float EPS = 1e-6f;
constexpr float LOG2E = 1.4426950408889634f;
constexpr float QSCALE_GLA = 0.08838834764831845f;
constexpr float QSCALE_FOX = 0.125f * LOG2E;

namespace pg8 {
#define PG8_LAS __attribute__((address_space(3)))
typedef unsigned short bf16_t;
typedef short bf16x8 __attribute__((ext_vector_type(8)));
typedef float f32x4 __attribute__((ext_vector_type(4)));
typedef unsigned u32x4 __attribute__((ext_vector_type(4)));
typedef unsigned u32x2 __attribute__((ext_vector_type(2)));
constexpr int BM = 256, BK = 64, HALF = 128, HTB = HALF * BK * 2, STAGE_BYTES = 8 * HTB, NXCD = 8, WGM = 8;

__host__ __device__ __forceinline__ int lds_byte(int r, int c) { const int st = (r >> 4) * 2 + (c >> 5), rr = r & 15, cc = c & 31, ob = rr * 64 + cc * 2; return st * 1024 + (ob ^ (((ob >> 9) & 1) << 5)); }
__host__ __device__ __forceinline__ void stage_rc(int b, int& R, int& C) { const int st = b / 1024, sb = b % 1024, swz = sb ^ (((sb >> 9) & 1) << 5); R = (st >> 1) * 16 + swz / 64; C = (st & 1) * 32 + (swz % 64) / 2; }
__host__ __device__ __forceinline__ int perm32(int rho) { const int n = rho >> 4, i = rho & 15; return 8 * (i >> 2) + 4 * n + (i & 3); }

struct Unit { int pm, pn; };
struct Gemm { const bf16_t* A; const bf16_t* Bt; int M, N, K; };

struct StaticOrder {
    int nM, nN, nwg, G, c;
    __host__ __device__ void init(int M, int N, int G_, int c_) { nM = M / BM; nN = N / BM; nwg = nM * nN; G = G_; c = c_; }
    __host__ __device__ bool next(int i, Unit& u) const {
        const long L = (long)i * G + c; if (L >= nwg) return false;
        int wgid = (int)L; { const int q = nwg / NXCD, r = nwg % NXCD, xcd = wgid % NXCD, off = wgid / NXCD; wgid = (xcd < r ? xcd * (q + 1) : r * (q + 1) + (xcd - r) * q) + off; }
        const int nig = WGM * nN, gid = wgid / nig, fm = gid * WGM, gsz = (nM - fm) < WGM ? (nM - fm) : WGM;
        u.pm = fm + ((wgid % nig) % gsz); u.pn = (wgid % nig) / gsz; return true;
    }
    __device__ __forceinline__ void a_ready(const Unit&) const {}
    __device__ __forceinline__ void done(const Unit&) const {}
};

__device__ __forceinline__ unsigned cvt_pk_bf16(float lo, float hi) { unsigned r; asm volatile("v_cvt_pk_bf16_f32 %0, %1, %2" : "=v"(r) : "v"(lo), "v"(hi)); return r; }

__device__ __forceinline__ float rstd_row(const float* part, int row) {
    const f32x4* p = (const f32x4*)(part + (size_t)row * 16);
    const f32x4 a = p[0], b = p[1], c = p[2], d = p[3];
    const float s = (((a[0] + a[1]) + (a[2] + a[3])) + ((b[0] + b[1]) + (b[2] + b[3]))) + (((c[0] + c[1]) + (c[2] + c[3])) + ((d[0] + d[1]) + (d[2] + d[3])));
    return 1.0f / sqrtf(s * (1.0f / 1024.0f) + EPS);
}
__device__ __forceinline__ float silu_f(float x) { return x * __builtin_amdgcn_rcpf(1.0f + __builtin_amdgcn_exp2f(-x * LOG2E)); }

struct EpiRowScaleBf16 {
    static constexpr bool PERM = true, AFTER_DRAIN = false, SEG = false;
    bf16_t* O; int ldc; const float* part; int split_cols; bf16_t* O1; bf16_t* O2;
    __device__ __forceinline__ void operator()(const f32x4 (&acc)[2][2][4][2], const Unit& u, int wr, int wc, int fr, int fq) const {
        const int row0 = u.pm * BM + wr * 64 + fr; int colt = u.pn * BM; bf16_t* base = O;
        if (split_cols) { const int t = colt / split_cols; base = (t == 0) ? O : (t == 1 ? O1 : O2); colt -= t * split_cols; }
        const int col0 = colt + wc * 32 + 8 * fq;
#pragma unroll
        for (int ai = 0; ai < 2; ++ai)
#pragma unroll
            for (int m = 0; m < 4; ++m) { const int row = row0 + ai * HALF + m * 16; const float rs = rstd_row(part, row); bf16_t* rowp = base + (size_t)row * ldc + col0;
#pragma unroll
                for (int bj = 0; bj < 2; ++bj) { const f32x4 v0 = acc[ai][bj][m][0] * rs, v1 = acc[ai][bj][m][1] * rs;
                    u32x4 w; w.x = cvt_pk_bf16(v0[0], v0[1]); w.y = cvt_pk_bf16(v0[2], v0[3]); w.z = cvt_pk_bf16(v1[0], v1[1]); w.w = cvt_pk_bf16(v1[2], v1[3]);
                    *(u32x4*)(rowp + bj * HALF) = w; }
                asm volatile("" ::: "memory"); }
    }
};
struct EpiSwiglu {
    static constexpr bool PERM = true, AFTER_DRAIN = false, SEG = false;
    bf16_t* O; int ldc; const float* part;
    __device__ __forceinline__ void operator()(const f32x4 (&acc)[2][2][4][2], const Unit& u, int wr, int wc, int fr, int fq) const {
        const int row0 = u.pm * BM + wr * 64 + fr; const int col0 = u.pn * HALF + wc * 32 + 8 * fq;
#pragma unroll
        for (int ai = 0; ai < 2; ++ai)
#pragma unroll
            for (int m = 0; m < 4; ++m) { const int row = row0 + ai * HALF + m * 16; const float rs = rstd_row(part, row);
                const f32x4 g0 = acc[ai][0][m][0] * rs, g1 = acc[ai][0][m][1] * rs, u0 = acc[ai][1][m][0] * rs, u1 = acc[ai][1][m][1] * rs;
                float a[8];
#pragma unroll
                for (int i = 0; i < 4; ++i) { a[i] = silu_f(g0[i]) * u0[i]; a[4 + i] = silu_f(g1[i]) * u1[i]; }
                u32x4 w; w.x = cvt_pk_bf16(a[0], a[1]); w.y = cvt_pk_bf16(a[2], a[3]); w.z = cvt_pk_bf16(a[4], a[5]); w.w = cvt_pk_bf16(a[6], a[7]);
                *(u32x4*)(O + (size_t)row * ldc + col0) = w;
                asm volatile("" ::: "memory"); }
    }
};
struct EpiResid {
    static constexpr bool PERM = true, AFTER_DRAIN = false, SEG = false;
    const float* base32; bf16_t* hi; bf16_t* lo; float* part_out;
    __device__ __forceinline__ void operator()(const f32x4 (&acc)[2][2][4][2], const Unit& u, int wr, int wc, int fr, int fq) const {
        const int row0 = u.pm * BM + wr * 64 + fr, col0 = u.pn * BM + wc * 32 + 8 * fq;
#pragma unroll
        for (int ai = 0; ai < 2; ++ai)
#pragma unroll
            for (int m = 0; m < 4; ++m) { const int row = row0 + ai * HALF + m * 16; const size_t off = (size_t)row * DM + col0; float ss = 0.f;
#pragma unroll
                for (int bj = 0; bj < 2; ++bj) {
                    float h[8];
                    if (base32) { const f32x4 b0 = *(const f32x4*)(base32 + off + bj * HALF), b1 = *(const f32x4*)(base32 + off + bj * HALF + 4);
#pragma unroll
                        for (int i = 0; i < 4; ++i) { h[i] = b0[i]; h[4 + i] = b1[i]; } }
                    else { const u32x4 a = *(const u32x4*)(hi + off + bj * HALF), b = *(const u32x4*)(lo + off + bj * HALF);
#pragma unroll
                        for (int i = 0; i < 4; ++i) { h[2 * i] = __builtin_bit_cast(float, a[i] << 16) + __builtin_bit_cast(float, b[i] << 16); h[2 * i + 1] = __builtin_bit_cast(float, a[i] & 0xffff0000u) + __builtin_bit_cast(float, b[i] & 0xffff0000u); } }
#pragma unroll
                    for (int i = 0; i < 4; ++i) { h[i] += acc[ai][bj][m][0][i]; h[4 + i] += acc[ai][bj][m][1][i]; }
                    u32x4 wh, wl;
#pragma unroll
                    for (int i = 0; i < 4; ++i) { ss += h[2 * i] * h[2 * i] + h[2 * i + 1] * h[2 * i + 1];
                        const unsigned ph = cvt_pk_bf16(h[2 * i], h[2 * i + 1]);
                        const float r0 = h[2 * i] - __builtin_bit_cast(float, ph << 16), r1 = h[2 * i + 1] - __builtin_bit_cast(float, ph & 0xffff0000u);
                        wh[i] = ph; wl[i] = cvt_pk_bf16(r0, r1); }
                    *(u32x4*)(hi + off + bj * HALF) = wh; *(u32x4*)(lo + off + bj * HALF) = wl; }
                ss += __shfl_xor(ss, 16); ss += __shfl_xor(ss, 32);
                if (fq == 0) part_out[(size_t)row * 16 + u.pn * 4 + wc] = ss;
                asm volatile("" ::: "memory"); }
    }
};

struct EpiResidSeg {
    static constexpr bool PERM = true, AFTER_DRAIN = false, SEG = true;
    const float* base32; bf16_t* hi; bf16_t* lo; float* part_out; const float* hpart; PG8_LAS float* tbl;
    __device__ __forceinline__ void seg_fill(const Unit& u, int slot) const {
        int tid_ = threadIdx.x; asm volatile("" : "+v"(tid_));
        const int row = tid_ >> 1, half = tid_ & 1;
        const f32x4* hp = (const f32x4*)(hpart + (size_t)(u.pm * BM + row) * 32);
        float sh[4];
#pragma unroll
        for (int h = 0; h < 4; ++h) { const f32x4 a = hp[2 * h], b = hp[2 * h + 1]; const float ss = ((a[0] + a[1]) + (a[2] + a[3])) + ((b[0] + b[1]) + (b[2] + b[3])); sh[h] = 1.0f / sqrtf(ss * (1.0f / 256.0f) + EPS); }
        typedef float f32x2v __attribute__((ext_vector_type(2)));
        const f32x2v w = half ? (f32x2v){sh[2] / sh[3], sh[3]} : (f32x2v){sh[0] / sh[1], sh[1] / sh[2]};
        *(PG8_LAS f32x2v*)(tbl + slot * 1024 + row * 4 + 2 * half) = w;
    }
    __device__ __forceinline__ void seg_scale(f32x4 (&acc)[2][2][4][2], int j, int slot, int wr, int fr) const {
#pragma unroll
        for (int ai = 0; ai < 2; ++ai)
#pragma unroll
            for (int m = 0; m < 4; ++m) { const float r = tbl[slot * 1024 + (ai * HALF + wr * 64 + m * 16 + fr) * 4 + (j - 1)];
#pragma unroll
                for (int bj = 0; bj < 2; ++bj)
#pragma unroll
                    for (int n = 0; n < 2; ++n) acc[ai][bj][m][n] = acc[ai][bj][m][n] * r; }
    }
    __device__ __forceinline__ void operator()(const f32x4 (&acc)[2][2][4][2], const Unit& u, int wr, int wc, int fr, int fq, int slot) const {
        const int row0 = u.pm * BM + wr * 64 + fr, col0 = u.pn * BM + wc * 32 + 8 * fq;
#pragma unroll
        for (int ai = 0; ai < 2; ++ai)
#pragma unroll
            for (int m = 0; m < 4; ++m) { const int row = row0 + ai * HALF + m * 16; const size_t off = (size_t)row * DM + col0; float ss = 0.f;
                const float s3 = tbl[slot * 1024 + (ai * HALF + wr * 64 + m * 16 + fr) * 4 + 3];
#pragma unroll
                for (int bj = 0; bj < 2; ++bj) {
                    float h[8];
                    if (base32) { const f32x4 b0 = *(const f32x4*)(base32 + off + bj * HALF), b1 = *(const f32x4*)(base32 + off + bj * HALF + 4);
#pragma unroll
                        for (int i = 0; i < 4; ++i) { h[i] = b0[i]; h[4 + i] = b1[i]; } }
                    else { const u32x4 a = *(const u32x4*)(hi + off + bj * HALF), b = *(const u32x4*)(lo + off + bj * HALF);
#pragma unroll
                        for (int i = 0; i < 4; ++i) { h[2 * i] = __builtin_bit_cast(float, a[i] << 16) + __builtin_bit_cast(float, b[i] << 16); h[2 * i + 1] = __builtin_bit_cast(float, a[i] & 0xffff0000u) + __builtin_bit_cast(float, b[i] & 0xffff0000u); } }
#pragma unroll
                    for (int i = 0; i < 4; ++i) { h[i] += acc[ai][bj][m][0][i] * s3; h[4 + i] += acc[ai][bj][m][1][i] * s3; }
                    u32x4 wh, wl;
#pragma unroll
                    for (int i = 0; i < 4; ++i) { ss += h[2 * i] * h[2 * i] + h[2 * i + 1] * h[2 * i + 1];
                        const unsigned ph = cvt_pk_bf16(h[2 * i], h[2 * i + 1]);
                        const float r0 = h[2 * i] - __builtin_bit_cast(float, ph << 16), r1 = h[2 * i + 1] - __builtin_bit_cast(float, ph & 0xffff0000u);
                        wh[i] = ph; wl[i] = cvt_pk_bf16(r0, r1); }
                    *(u32x4*)(hi + off + bj * HALF) = wh; *(u32x4*)(lo + off + bj * HALF) = wl; }
                ss += __shfl_xor(ss, 16); ss += __shfl_xor(ss, 32);
                if (fq == 0) part_out[(size_t)row * 16 + u.pn * 4 + wc] = ss;
                asm volatile("" ::: "memory"); }
    }
};

template <class Epi, class Sched, bool ALIGN_EPI = false, bool SP2 = false>
__device__ __forceinline__ void gemm_phase(PG8_LAS unsigned char* lds, const Gemm g, const Sched& S, const Epi& E) {
    int tid_ = threadIdx.x; asm volatile("" : "+v"(tid_));
    const int tid = tid_, wid = __builtin_amdgcn_readfirstlane(tid >> 6), lane = tid & 63, wr = wid >> 2, wc = wid & 3, fr = lane & 15, fq = lane >> 4;
    const int K = g.K, nt = K / BK;
    unsigned voffA[2], voffB[2];
#pragma unroll
    for (int i = 0; i < 2; ++i) { int R, C; stage_rc(tid * 16 + i * 8192, R, C); const int Rb = Epi::PERM ? ((R & ~31) + perm32(R & 31)) : R;
        voffA[i] = (unsigned)(R * K + C) * 2u; voffB[i] = (unsigned)(Rb * K + C) * 2u; }
    const size_t kstep = (size_t)(BK * 2);
    const size_t hstep = (size_t)HALF * K * 2;
    const size_t tstep = 2 * hstep;
    const unsigned ldsw = (unsigned)wid * 1024u;
    const int aoff = lds_byte(wr * 64 + fr, fq * 8), boff = lds_byte(wc * 32 + fr, fq * 8);
#define PG8_SA(b, h) (((b) * 2 + (h)) * HTB)
#define PG8_SB(b, h) ((4 + (b) * 2 + (h)) * HTB)
#define PG8_STAGE(bufoff, gbase, voff) do { _Pragma("unroll") for (int _i = 0; _i < 2; ++_i) \
        __builtin_amdgcn_global_load_lds((const unsigned*)((const char*)(gbase) + (voff)[_i]), (PG8_LAS unsigned*)(lds + (bufoff) + ldsw + _i * 8192), 16, 0, 0); } while (0)
#define PG8_LDA(dst, b, h) do { _Pragma("unroll") for (int m = 0; m < 4; ++m) _Pragma("unroll") for (int k = 0; k < 2; ++k) dst[m][k] = *(const PG8_LAS bf16x8*)(lds + PG8_SA(b, h) + aoff + m * 2048 + k * 1024); } while (0)
#define PG8_LDB(dst, b, h) do { _Pragma("unroll") for (int n = 0; n < 2; ++n) _Pragma("unroll") for (int k = 0; k < 2; ++k) dst[n][k] = *(const PG8_LAS bf16x8*)(lds + PG8_SB(b, h) + boff + n * 2048 + k * 1024); } while (0)
#define PG8_MMA(ai, bj, At, Bt) do { __builtin_amdgcn_s_setprio(1); _Pragma("unroll") for (int m = 0; m < 4; ++m) _Pragma("unroll") for (int n = 0; n < 2; ++n) _Pragma("unroll") for (int k = 0; k < 2; ++k) \
        acc[ai][bj][m][n] = __builtin_amdgcn_mfma_f32_16x16x32_bf16(Bt[n][k], At[m][k], acc[ai][bj][m][n], 0, 0, 0); __builtin_amdgcn_s_setprio(0); } while (0)
#define PG8_WAIT_V(n) asm volatile("s_waitcnt vmcnt(" #n ")" ::: "memory")
#define PG8_WAIT_L(n) asm volatile("s_waitcnt lgkmcnt(" #n ")" ::: "memory")
#define PG8_BAR __builtin_amdgcn_s_barrier()
#define PG8_SCHED __builtin_amdgcn_sched_barrier(0)
    Unit cur, nxt; int ui = 0;
    if (!S.next(0, cur)) return;
    f32x4 acc[2][2][4][2];
#pragma unroll
    for (int a = 0; a < 2; ++a)
#pragma unroll
        for (int b = 0; b < 2; ++b)
#pragma unroll
            for (int m = 0; m < 4; ++m)
#pragma unroll
                for (int n = 0; n < 2; ++n) acc[a][b][m][n] = (f32x4){0.f, 0.f, 0.f, 0.f};
    bf16x8 At[4][2], B0[2][2], B1[2][2];
    const char* cA = (const char*)g.A + (size_t)cur.pm * tstep; const char* cB = (const char*)g.Bt + (size_t)cur.pn * tstep;
    S.a_ready(cur);
    if constexpr (Epi::SEG) E.seg_fill(cur, 0);
    if constexpr (SP2) {
        PG8_STAGE(PG8_SB(0, 0), cB, voffB); PG8_STAGE(PG8_SB(0, 1), cB + hstep, voffB); PG8_STAGE(PG8_SA(0, 0), cA, voffA); PG8_STAGE(PG8_SA(0, 1), cA + hstep, voffA);
        if (wr == 1) PG8_BAR;
        PG8_WAIT_V(2); PG8_BAR;
        PG8_STAGE(PG8_SB(1, 0), cB + kstep, voffB); PG8_STAGE(PG8_SA(1, 0), cA + kstep, voffA); PG8_STAGE(PG8_SB(1, 1), cB + hstep + kstep, voffB);
        PG8_WAIT_V(6); PG8_BAR;
    } else {
        PG8_STAGE(PG8_SB(0, 0), cB, voffB); PG8_STAGE(PG8_SA(0, 0), cA, voffA); PG8_STAGE(PG8_SB(0, 1), cB + hstep, voffB); PG8_STAGE(PG8_SA(0, 1), cA + hstep, voffA);
        if (wr == 1) PG8_BAR;
        PG8_WAIT_V(4); PG8_BAR;
        PG8_STAGE(PG8_SB(1, 0), cB + kstep, voffB); PG8_STAGE(PG8_SA(1, 0), cA + kstep, voffA); PG8_STAGE(PG8_SB(1, 1), cB + hstep + kstep, voffB);
        PG8_WAIT_V(6); PG8_BAR;
    }
    for (;;) {
        const bool has_next = S.next(ui + 1, nxt);
        const char* nA = has_next ? (const char*)g.A + (size_t)nxt.pm * tstep : cA; const char* nB = has_next ? (const char*)g.Bt + (size_t)nxt.pn * tstep : cB;
        for (int t = 0; t < nt; t += 2) {
            const bool last = (t == nt - 2);
            const char* a1 = cA + (size_t)(t + 1) * kstep;
            const char* a2 = last ? nA : cA + (size_t)(t + 2) * kstep; const char* b2 = last ? nB : cB + (size_t)(t + 2) * kstep;
            const char* a3 = a2 + kstep; const char* b3 = b2 + kstep;
            if (last && has_next) S.a_ready(nxt);
            if constexpr (Epi::SEG) { if (t == 4 || t == 8 || t == 12) E.seg_scale(acc, t >> 2, ui & 1, wr, fr); }
            if constexpr (SP2) {
            PG8_LDB(B0, 0, 0); PG8_LDB(B1, 0, 1); PG8_SCHED; PG8_LDA(At, 0, 0); PG8_STAGE(PG8_SA(1, 1), a1 + hstep, voffA);
            PG8_WAIT_V(8); PG8_WAIT_L(0); PG8_BAR; PG8_MMA(0, 0, At, B0); PG8_MMA(0, 1, At, B1); PG8_BAR; PG8_SCHED;
            PG8_LDA(At, 0, 1); PG8_STAGE(PG8_SB(0, 0), b2, voffB); PG8_STAGE(PG8_SB(0, 1), b2 + hstep, voffB); PG8_STAGE(PG8_SA(0, 0), a2, voffA);
            PG8_WAIT_V(8); PG8_WAIT_L(0); PG8_BAR; PG8_MMA(1, 0, At, B0); PG8_MMA(1, 1, At, B1); PG8_BAR; PG8_SCHED;
            PG8_LDB(B0, 1, 0); PG8_LDB(B1, 1, 1); PG8_SCHED; PG8_LDA(At, 1, 0); PG8_STAGE(PG8_SA(0, 1), a2 + hstep, voffA);
            PG8_WAIT_V(8); PG8_WAIT_L(0); PG8_BAR; PG8_MMA(0, 0, At, B0); PG8_MMA(0, 1, At, B1); PG8_BAR; PG8_SCHED;
            PG8_LDA(At, 1, 1); PG8_STAGE(PG8_SB(1, 0), b3, voffB); PG8_STAGE(PG8_SB(1, 1), b3 + hstep, voffB); PG8_STAGE(PG8_SA(1, 0), a3, voffA);
            PG8_WAIT_V(8); PG8_WAIT_L(0); PG8_BAR; PG8_MMA(1, 0, At, B0); PG8_MMA(1, 1, At, B1); PG8_BAR; PG8_SCHED;
            } else {
            PG8_LDB(B0, 0, 0); PG8_SCHED; PG8_LDA(At, 0, 0); PG8_STAGE(PG8_SA(1, 1), a1 + hstep, voffA);
            PG8_WAIT_L(8); PG8_BAR; PG8_WAIT_L(0); PG8_MMA(0, 0, At, B0); PG8_BAR; PG8_SCHED;
            PG8_LDB(B1, 0, 1); PG8_STAGE(PG8_SB(0, 0), b2, voffB);
            PG8_BAR; PG8_WAIT_L(0); PG8_MMA(0, 1, At, B1); PG8_BAR;
            PG8_LDA(At, 0, 1); PG8_STAGE(PG8_SA(0, 0), a2, voffA);
            PG8_BAR; PG8_WAIT_L(0); PG8_MMA(1, 0, At, B0); PG8_BAR; PG8_SCHED;
            PG8_STAGE(PG8_SB(0, 1), b2 + hstep, voffB);
            PG8_WAIT_V(6); PG8_BAR; PG8_MMA(1, 1, At, B1); PG8_BAR;
            PG8_LDB(B0, 1, 0); PG8_SCHED; PG8_LDA(At, 1, 0); PG8_STAGE(PG8_SA(0, 1), a2 + hstep, voffA);
            PG8_WAIT_L(8); PG8_BAR; PG8_WAIT_L(0); PG8_MMA(0, 0, At, B0); PG8_BAR; PG8_SCHED;
            PG8_LDB(B1, 1, 1); PG8_STAGE(PG8_SB(1, 0), b3, voffB);
            PG8_BAR; PG8_WAIT_L(0); PG8_MMA(0, 1, At, B1); PG8_BAR;
            PG8_LDA(At, 1, 1); PG8_STAGE(PG8_SA(1, 0), a3, voffA);
            PG8_BAR; PG8_WAIT_L(0); PG8_MMA(1, 0, At, B0); PG8_BAR; PG8_SCHED;
            PG8_STAGE(PG8_SB(1, 1), b3 + hstep, voffB);
            PG8_WAIT_V(6); PG8_BAR; PG8_MMA(1, 1, At, B1); PG8_BAR;
            }
        }
        if constexpr (ALIGN_EPI) { if (wr == 0) PG8_BAR; }
        if constexpr (Epi::SEG) { E(acc, cur, wr, wc, fr, fq, ui & 1); if (has_next) E.seg_fill(nxt, (ui + 1) & 1); S.done(cur); }
        else if constexpr (!Epi::AFTER_DRAIN) { E(acc, cur, wr, wc, fr, fq); S.done(cur); }
        if (!has_next) break;
#pragma unroll
        for (int a = 0; a < 2; ++a)
#pragma unroll
            for (int b = 0; b < 2; ++b)
#pragma unroll
                for (int m = 0; m < 4; ++m)
#pragma unroll
                    for (int n = 0; n < 2; ++n) acc[a][b][m][n] = (f32x4){0.f, 0.f, 0.f, 0.f};
        cur = nxt; cA = nA; cB = nB; ++ui;
        if constexpr (ALIGN_EPI) { if (wr == 1) PG8_BAR; }
    }
    PG8_WAIT_V(0);
    if constexpr (!ALIGN_EPI) { if (wr == 0) PG8_BAR; }
    PG8_BAR;
#undef PG8_SA
#undef PG8_SB
#undef PG8_STAGE
#undef PG8_LDA
#undef PG8_LDB
#undef PG8_MMA
#undef PG8_WAIT_V
#undef PG8_WAIT_L
#undef PG8_BAR
#undef PG8_SCHED
}
}

namespace attn_body {
using bf16=__hip_bfloat16;
using bf16x8=__attribute__((ext_vector_type(8)))short;
using s16x4=__attribute__((ext_vector_type(4)))short;
using f32x16=__attribute__((ext_vector_type(16)))float;
using f32x4=__attribute__((ext_vector_type(4)))float;
using u32x4=__attribute__((ext_vector_type(4)))unsigned;
constexpr int NHEAD=16,D=64,DMA=NHEAD*D;
constexpr int NW=8,QBLK=32,QB=QBLK*NW,KVBLK=64,NQB=SEQ/QB;
__device__ __forceinline__ int crow(int r,int hi){return (r&3)+8*(r>>2)+4*hi;}
#define SBAR() __builtin_amdgcn_sched_barrier(0)
__device__ __forceinline__ void cmask(f32x16&p0,f32x16&p1,int jb,int qrel,int hi){
  const float NEG=-INFINITY; int kb=64*jb+4*hi;
  #pragma unroll
  for(int r=0;r<16;++r){int kv=kb+(r&3)+8*(r>>2); if(kv>qrel)p0[r]=NEG; if(kv+32>qrel)p1[r]=NEG;}
}
constexpr int NSLOT=3, SLOTB=8192;
constexpr int LDS_K=0, LDS_V=NSLOT*SLOTB, LDS_WS=2*NSLOT*SLOTB, LDS_OST=LDS_WS+NW*64*4, LDS_BYTES=LDS_OST+NW*4096;
constexpr int LDS_BIAS=LDS_BYTES, LDS_BIAS_BYTES=SEQ*4, LDS_SCAN=LDS_BIAS+LDS_BIAS_BYTES, LDS_TOTAL=LDS_SCAN+64;
__device__ __forceinline__ void glds16(const void*gsrc,unsigned lds_dst){unsigned keep;
  asm volatile("s_mov_b32 %0, m0\n\ts_mov_b32 m0, %2\n\ts_nop 0\n\tglobal_load_lds_dwordx4 %1, off\n\ts_mov_b32 m0, %0":"=&s"(keep):"v"(gsrc),"s"(lds_dst):"memory");}
__device__ __forceinline__ float max3f(float a,float b,float c){float r;asm("v_max3_f32 %0, %1, %2, %3":"=v"(r):"v"(a),"v"(b),"v"(c));return r;}
__device__ __forceinline__ float max2f(float a,float b){float r;asm("v_max_f32_e32 %0, %1, %2":"=v"(r):"v"(a),"v"(b));return r;}
__device__ __forceinline__ float fadd_s(float a,float b){float r;asm("v_add_f32_e32 %0, %1, %2":"=v"(r):"v"(a),"v"(b));return r;}
__device__ __forceinline__ float fsub_s(float a,float b){float r;asm("v_sub_f32_e32 %0, %1, %2":"=v"(r):"v"(a),"v"(b));return r;}
typedef float f32x2_t __attribute__((ext_vector_type(2))); typedef __bf16 bf16x2_t __attribute__((ext_vector_type(2)));
__device__ __forceinline__ unsigned cvtpk_s(float lo,float hi){f32x2_t v={lo,hi};bf16x2_t b=__builtin_convertvector(v,bf16x2_t);return __builtin_bit_cast(unsigned,b);}
#define WAIT_BAR(N) asm volatile("s_waitcnt vmcnt(" #N ") lgkmcnt(0)\n\ts_barrier":::"memory")

__device__ __forceinline__ void qkt(f32x16&p0,f32x16&p1,const char*Kslot,const bf16x8*qr,bf16x8 ak0,bf16x8 ak1,bf16x8 bq,int r32,int hi){
  const char*kb=Kslot+hi*1024+r32*16; const f32x16 z=f32x16{};
  p0=__builtin_amdgcn_mfma_f32_32x32x16_bf16(ak0,bq,z,0,0,0);p1=__builtin_amdgcn_mfma_f32_32x32x16_bf16(ak1,bq,z,0,0,0);
  #pragma unroll
  for(int d0=0;d0<4;++d0){
    const bf16x8 b0=*reinterpret_cast<const bf16x8*>(kb+d0*2048);
    const bf16x8 b1=*reinterpret_cast<const bf16x8*>(kb+d0*2048+512);
    p0=__builtin_amdgcn_mfma_f32_32x32x16_bf16(b0,qr[d0],p0,0,0,0);p1=__builtin_amdgcn_mfma_f32_32x32x16_bf16(b1,qr[d0],p1,0,0,0);}
}
typedef __attribute__((address_space(3))) const char* lds_cptr;
typedef short v4i16_t __attribute__((ext_vector_type(4)));
__device__ __forceinline__ void kload8(bf16x8*kf,lds_cptr kp){
  kf[0]=*(const __attribute__((address_space(3))) bf16x8*)(kp);      kf[1]=*(const __attribute__((address_space(3))) bf16x8*)(kp+512);
  kf[2]=*(const __attribute__((address_space(3))) bf16x8*)(kp+2048); kf[3]=*(const __attribute__((address_space(3))) bf16x8*)(kp+2560);
  kf[4]=*(const __attribute__((address_space(3))) bf16x8*)(kp+4096); kf[5]=*(const __attribute__((address_space(3))) bf16x8*)(kp+4608);
  kf[6]=*(const __attribute__((address_space(3))) bf16x8*)(kp+6144); kf[7]=*(const __attribute__((address_space(3))) bf16x8*)(kp+6656);
}
__device__ __forceinline__ void kload2(bf16x8*kf,lds_cptr kp,int j){ kf[2*j]=*(const __attribute__((address_space(3))) bf16x8*)(kp+j*2048); kf[2*j+1]=*(const __attribute__((address_space(3))) bf16x8*)(kp+j*2048+512); }
__device__ __forceinline__ s16x4 vtr(lds_cptr p){ return __builtin_bit_cast(s16x4,__builtin_amdgcn_ds_read_tr16_b64_v4i16((__attribute__((address_space(3))) v4i16_t*)p)); }
__device__ __forceinline__ float rowmax(const f32x16&p0,const f32x16&p1){
  float a=max3f(p0[0],p0[1],p1[0]),b=max3f(p0[2],p0[3],p1[1]);a=max3f(a,p1[2],p1[3]);
  #pragma unroll
  for(int r=4;r<16;r+=4){a=max3f(a,p0[r],p0[r+1]);b=max3f(b,p0[r+2],p0[r+3]);a=max3f(a,p1[r],p1[r+1]);b=max3f(b,p1[r+2],p1[r+3]);}
  const float m=max2f(a,b);
  auto rr=__builtin_amdgcn_permlane32_swap(__float_as_uint(m),__float_as_uint(m),false,false);
  return max2f(__uint_as_float(rr[0]),__uint_as_float(rr[1]));
}
__device__ __forceinline__ void pv(f32x16*o,int vb,bf16x8 pa0,bf16x8 pa1,bf16x8 pa2,bf16x8 pa3){
  #pragma unroll
  for(int d0=0;d0<2;++d0){s16x4 lo[4],hi[4];
    #pragma unroll
    for(int ks=0;ks<4;++ks){
      asm volatile("ds_read_b64_tr_b16 %0,%1 offset:%c2":"=&v"(lo[ks]):"v"(vb),"i"(d0*4096+ks*1024):"memory");
      asm volatile("ds_read_b64_tr_b16 %0,%1 offset:%c2":"=&v"(hi[ks]):"v"(vb),"i"(d0*4096+ks*1024+512):"memory");}
    asm volatile("s_waitcnt lgkmcnt(0)":::"memory");SBAR();
    #define PK(k) (bf16x8){lo[k][0],lo[k][1],lo[k][2],lo[k][3],hi[k][0],hi[k][1],hi[k][2],hi[k][3]}
    o[d0]=__builtin_amdgcn_mfma_f32_32x32x16_bf16(pa0,PK(0),o[d0],0,0,0);
    o[d0]=__builtin_amdgcn_mfma_f32_32x32x16_bf16(pa1,PK(1),o[d0],0,0,0);
    o[d0]=__builtin_amdgcn_mfma_f32_32x32x16_bf16(pa2,PK(2),o[d0],0,0,0);
    o[d0]=__builtin_amdgcn_mfma_f32_32x32x16_bf16(pa3,PK(3),o[d0],0,0,0);
    #undef PK
  }
}
__device__ __forceinline__ void split3(float x,unsigned&p0,unsigned&p1,unsigned&p2){
  p0=cvtpk_s(x,0.f)&0xffffu; const float r1=x-__uint_as_float(p0<<16);
  p1=cvtpk_s(r1,0.f)&0xffffu; const float r2=r1-__uint_as_float(p1<<16);
  p2=cvtpk_s(r2,0.f)&0xffffu; }
__device__ __forceinline__ bf16x8 mk_akey(float bias,int hi){ unsigned p0,p1,p2; split3(bias,p0,p1,p2);
  u32x4 w; w.x=p0|(p1<<16); w.y=p2|0x3f800000u; w.z=0x3f803f80u; w.w=0u; if(hi)w=(u32x4){0u,0u,0u,0u}; return __builtin_bit_cast(bf16x8,w); }
__device__ __forceinline__ bf16x8 mk_bqry(float mhat,int hi){ unsigned n0,n1,n2; split3(-mhat,n0,n1,n2);
  u32x4 w; w.x=0x3f803f80u; w.y=0x3f80u|(n0<<16); w.z=n1|(n2<<16); w.w=0u; if(hi)w=(u32x4){0u,0u,0u,0u}; return __builtin_bit_cast(bf16x8,w); }

#ifndef ATTN_STORE16
#define ATTN_STORE16(p,v) (*(u32x4*)(p)=(v))
#endif
template<int THRL> __device__ __forceinline__ void attn_unit(int b,int h,int qb,int t0,const bf16*Q,const bf16*__restrict__ K,const bf16*__restrict__ V,bf16*O,char*shm){
  int tid_=threadIdx.x; asm volatile("":"+v"(tid_));
  const int tid=tid_,lane=tid&63,r32=lane&31,hi=lane>>5; const int wid=__builtin_amdgcn_readfirstlane(tid>>6);
  const long rowbase=(long)b*SEQ; const int q0=qb*QB;
  const bf16*Qw=Q+(rowbase+q0+wid*QBLK)*DMA+h*D;
  const bf16*Kh=K+(rowbase+(long)t0*KVBLK)*DMA+h*D,*Vh=V+(rowbase+(long)t0*KVBLK)*DMA+h*D;
  const unsigned lds0=(unsigned)(uintptr_t)shm;
  float*wsf=(float*)(shm+LDS_WS)+wid*64;
  const __attribute__((address_space(3))) float*btq=(const __attribute__((address_space(3))) float*)((lds_cptr)shm+LDS_BIAS);
  const __attribute__((address_space(3))) float*bt=btq+t0*KVBLK;
  const bf16*ksrc=Kh+(long)lane*DMA+wid*8;
  const bf16*vsrc=Vh+(long)(16*(wid&3)+(lane>>2))*DMA+(wid>>2)*32+(lane&3)*8;
  const unsigned kdst=lds0+LDS_K+wid*1024, vdst=lds0+LDS_V+wid*1024;
  #define DMA_K(t,slot) glds16(ksrc+(long)(t)*KVBLK*DMA,(unsigned)__builtin_amdgcn_readfirstlane(kdst+(slot)))
  #define DMA_V(t,slot) glds16(vsrc+(long)(t)*KVBLK*DMA,(unsigned)__builtin_amdgcn_readfirstlane(vdst+(slot)))
  const int vb0=(int)(lds0+LDS_V)+((lane>>4)&1)*32+(lane&3)*8+(4*hi+((lane&15)>>2))*64;
  const char*Kbase=shm+LDS_K; bf16x8 kf[8];
  const lds_cptr shm3=(lds_cptr)shm; const lds_cptr kp0=shm3+LDS_K+hi*1024+r32*16; const lds_cptr vp0=shm3+LDS_V+((lane>>4)&1)*32+(lane&3)*8+(4*hi+((lane&15)>>2))*64;
  const int NT=(q0+QB)/KVBLK-t0;
  DMA_K(0,0);DMA_V(0,0);DMA_K(1,SLOTB);
  bf16x8 qr[4];
  #pragma unroll
  for(int d0=0;d0<4;++d0)qr[d0]=*reinterpret_cast<const bf16x8*>(&Qw[(long)r32*DMA+d0*16+hi*8]);
  const int qrel=wid*QBLK+r32;
  float mhat=btq[q0+qrel],l_reg=0.f;f32x16 o[2];o[0]=f32x16{};o[1]=f32x16{};
  const f32x16 zero16=f32x16{}; bf16x8 bq=mk_bqry(mhat,hi);
  #define CMASK(P0,P1,t) do{int jb_=(t)-(NT-4); if(jb_>=0)cmask(P0,P1,jb_,qrel,hi);}while(0)
  bool resc=false;
  #define START(P0,P1) do{ const float rm=rowmax(P0,P1); resc=false; \
    { const float dl=rm; mhat=fadd_s(mhat,dl); \
      _Pragma("unroll") for(int r=0;r<16;++r){P0[r]=fsub_s(P0[r],dl);P1[r]=fsub_s(P1[r],dl);} bq=mk_bqry(mhat,hi); } \
    _Pragma("unroll") for(int r=0;r<16;++r)P0[r]=__builtin_amdgcn_exp2f(P0[r]); }while(0)
  #define RESC() do{ if(resc){ asm volatile("s_waitcnt lgkmcnt(0)":::"memory"); \
      _Pragma("unroll") for(int d_=0;d_<2;++d_) _Pragma("unroll") for(int r=0;r<16;++r)o[d_][r]*=wsf[crow(r,hi)]; } }while(0)
  f32x16 pA0,pA1,pB0,pB1;
  int sl_prev=0,sl_cur=0,sl_next=SLOTB;
  #define ROT() do{sl_prev=sl_cur;sl_cur=sl_next;sl_next=(sl_next==(NSLOT-1)*SLOTB)?0:sl_next+SLOTB;}while(0)
  DMA_K(2,2*SLOTB);
  WAIT_BAR(3);
  qkt(pA0,pA1,Kbase,qr,mk_akey(bt[r32],hi),mk_akey(bt[32+r32],hi),bq,r32,hi);asm volatile("s_nop 15\n\ts_nop 7":"+v"(pA0),"+v"(pA1));CMASK(pA0,pA1,0);
  START(pA0,pA1);
  bf16x8 akn0=mk_akey(bt[64+r32],hi), akn1=mk_akey(bt[96+r32],hi);
  float bn0=0.f,bn1=0.f;
  _Pragma("unroll") for(int r=0;r<16;++r)pA1[r]=__builtin_amdgcn_exp2f(pA1[r]);
  WAIT_BAR(0);
  DMA_K(3,0);DMA_V(1,SLOTB);
  ROT();
  kload8(kf,kp0+sl_cur);
  WAIT_BAR(2);
  s16x4 vlo[8],vhi[8]; u32x4 pw0,pw1,pw2,pw3;
  #define PKW(P,B) cvtpk_s(P[B],P[B+1])
  #define PAF(k) __builtin_bit_cast(bf16x8,pw##k)
  #define VFR(i) (bf16x8){vlo[i][0],vlo[i][1],vlo[i][2],vlo[i][3],vhi[i][0],vhi[i][1],vhi[i][2],vhi[i][3]}
  #define PIN(x) asm volatile("":"+v"(x))
  #define MX3(a,b,c) __builtin_fmaxf(__builtin_fmaxf((a),(b)),(c))
  #define GAPA(MF,A0,A1,A2,A3,W0,W1,PW) do{ MF; sacc+=A0; sacc+=A1; sacc+=A2; sacc+=A3; PIN(sacc); W0; W1; PIN(PW); SBAR(); }while(0)
  #define EX(v) __builtin_amdgcn_exp2f(v)
  #define GAPB(MF,X,B) do{ MF; X[B]=EX(X[B]); X[B+1]=EX(X[B+1]); X[B+2]=EX(X[B+2]); X[B+3]=EX(X[B+3]); PIN(X); SBAR(); }while(0)
  #define VRD(i) do{ vlo[i]=vtr(vp_+(((i)>>2)*4096+((i)&3)*1024)); vhi[i]=vtr(vp_+(((i)>>2)*4096+((i)&3)*1024+512)); }while(0)
  #define KRD(G,j) do{ if(G){ kload2(kf,kp0+sl_next,j); SBAR(); } }while(0)
  #define STEP(C0,C1,P0,P1,t,GK,GV,GL) do{ SBAR(); \
    const lds_cptr vp_=vp0+sl_prev; \
    C0=__builtin_amdgcn_mfma_f32_32x32x16_bf16(akn0,bq,zero16,0,0,0); C1=__builtin_amdgcn_mfma_f32_32x32x16_bf16(akn1,bq,zero16,0,0,0); \
    VRD(0); SBAR(); float sacc=(P0[0]+P0[1]); \
    GAPA(C0=__builtin_amdgcn_mfma_f32_32x32x16_bf16(kf[0],qr[0],C0,0,0,0), P0[2],P0[3],P0[4],P0[5],     pw0[0]=PKW(P0,0), pw0[1]=PKW(P0,2), pw0); \
    VRD(4); SBAR(); GAPA(C1=__builtin_amdgcn_mfma_f32_32x32x16_bf16(kf[1],qr[0],C1,0,0,0), P0[6],P0[7],P0[8],P0[9],     pw0[2]=PKW(P0,4), pw0[3]=PKW(P0,6), pw0); \
    VRD(1); SBAR(); GAPA(C0=__builtin_amdgcn_mfma_f32_32x32x16_bf16(kf[2],qr[1],C0,0,0,0),   P0[10],P0[11],P0[12],P0[13], pw1[0]=PKW(P0,8), pw1[1]=PKW(P0,10), pw1); \
    VRD(5); SBAR(); GAPA(C1=__builtin_amdgcn_mfma_f32_32x32x16_bf16(kf[3],qr[1],C1,0,0,0),   P0[14],P0[15],P1[0],P1[1],   pw1[2]=PKW(P0,12),pw1[3]=PKW(P0,14), pw1); \
    VRD(2); SBAR(); GAPA(C0=__builtin_amdgcn_mfma_f32_32x32x16_bf16(kf[4],qr[2],C0,0,0,0),   P1[2],P1[3],P1[4],P1[5],     pw2[0]=PKW(P1,0), pw2[1]=PKW(P1,2), pw2); \
    VRD(6); SBAR(); GAPA(C1=__builtin_amdgcn_mfma_f32_32x32x16_bf16(kf[5],qr[2],C1,0,0,0),   P1[6],P1[7],P1[8],P1[9],     pw2[2]=PKW(P1,4), pw2[3]=PKW(P1,6), pw2); \
    VRD(3); SBAR(); GAPA(C0=__builtin_amdgcn_mfma_f32_32x32x16_bf16(kf[6],qr[3],C0,0,0,0),   P1[10],P1[11],P1[12],P1[13], pw3[0]=PKW(P1,8), pw3[1]=PKW(P1,10), pw3); \
    VRD(7); SBAR(); GAPA(C1=__builtin_amdgcn_mfma_f32_32x32x16_bf16(kf[7],qr[3],C1,0,0,0),   P1[14],P1[15],0.f,0.f,       pw3[2]=PKW(P1,12),pw3[3]=PKW(P1,14), pw3); \
    l_reg+=sacc; \
    if(GK){DMA_K((t)+3,sl_cur);} if(GV){DMA_V((t)+1,sl_next);} \
    CMASK(C0,C1,t); \
    { float a=MX3(C0[0],C0[1],C1[0]),b=MX3(C0[2],C0[3],C1[1]); a=MX3(a,C1[2],C1[3]); \
      _Pragma("unroll") for(int r=4;r<16;r+=4){a=MX3(a,C0[r],C0[r+1]);b=MX3(b,C0[r+2],C0[r+3]);a=MX3(a,C1[r],C1[r+1]);b=MX3(b,C1[r+2],C1[r+3]);} \
      float rm=__builtin_fmaxf(a,b); { auto rr=__builtin_amdgcn_permlane32_swap(__float_as_uint(rm),__float_as_uint(rm),false,false); rm=__builtin_fmaxf(__uint_as_float(rr[0]),__uint_as_float(rr[1])); } \
      resc=false; \
      if(__builtin_expect(__any(rm>(float)THRL),0)){ const float dl=__builtin_fmaxf(rm,0.f); mhat+=dl; \
        _Pragma("unroll") for(int r=0;r<16;++r){C0[r]-=dl;C1[r]-=dl;} bq=mk_bqry(mhat,hi); \
        const float f=__builtin_amdgcn_exp2f(-dl); l_reg*=f; if(hi==0)wsf[r32]=f; resc=true; } } \
    SBAR(); \
    GAPB(o[0]=__builtin_amdgcn_mfma_f32_32x32x16_bf16(PAF(0),VFR(0),o[0],0,0,0), C0,0); \
    GAPB(o[1]=__builtin_amdgcn_mfma_f32_32x32x16_bf16(PAF(0),VFR(4),o[1],0,0,0), C0,4); \
    if(GL){ bn0=bt[64*((t)+1)+r32]; bn1=bt[64*((t)+1)+32+r32]; } \
    KRD(GL,0); GAPB(o[0]=__builtin_amdgcn_mfma_f32_32x32x16_bf16(PAF(1),VFR(1),o[0],0,0,0), C0,8); \
    KRD(GL,1); GAPB(o[1]=__builtin_amdgcn_mfma_f32_32x32x16_bf16(PAF(1),VFR(5),o[1],0,0,0), C0,12); \
    KRD(GL,2); GAPB(o[0]=__builtin_amdgcn_mfma_f32_32x32x16_bf16(PAF(2),VFR(2),o[0],0,0,0), C1,0); \
    KRD(GL,3); GAPB(o[1]=__builtin_amdgcn_mfma_f32_32x32x16_bf16(PAF(2),VFR(6),o[1],0,0,0), C1,4); \
    GAPB(o[0]=__builtin_amdgcn_mfma_f32_32x32x16_bf16(PAF(3),VFR(3),o[0],0,0,0), C1,8); \
    GAPB(o[1]=__builtin_amdgcn_mfma_f32_32x32x16_bf16(PAF(3),VFR(7),o[1],0,0,0), C1,12); \
    if(GL){ akn0=mk_akey(bn0,hi); akn1=mk_akey(bn1,hi); } \
    }while(0)
  int t=1;
  #undef CMASK
  #define CMASK(P0,P1,t) do{}while(0)
  for(;t+5<NT;t+=2){
    STEP(pB0,pB1,pA0,pA1,t,true,true,true);     WAIT_BAR(2); RESC(); ROT();
    STEP(pA0,pA1,pB0,pB1,t+1,true,true,true);   WAIT_BAR(2); RESC(); ROT();
  }
  #undef CMASK
  #define CMASK(P0,P1,t) do{int jb_=(t)-(NT-4); if(jb_>=0)cmask(P0,P1,jb_,qrel,hi);}while(0)
  #define ENDW(tt) do{ if((tt)+3<NT){WAIT_BAR(2);} else if((tt)+2<NT){WAIT_BAR(1);} else {WAIT_BAR(0);} }while(0)
  for(;t+1<NT;t+=2){
    STEP(pB0,pB1,pA0,pA1,t,(t+3<NT),(t+1<NT),(t+1<NT));       ENDW(t);   RESC(); ROT();
    STEP(pA0,pA1,pB0,pB1,t+1,(t+4<NT),(t+2<NT),(t+2<NT));     ENDW(t+1); RESC(); ROT();
  }
  STEP(pB0,pB1,pA0,pA1,NT-1,false,false,false); RESC();
  { float sacc=pB0[0]+pB0[1]; _Pragma("unroll") for(int r=2;r<16;++r)sacc+=pB0[r]; _Pragma("unroll") for(int r=0;r<16;++r)sacc+=pB1[r]; l_reg+=sacc;
    pw0=(u32x4){PKW(pB0,0),PKW(pB0,2),PKW(pB0,4),PKW(pB0,6)};pw1=(u32x4){PKW(pB0,8),PKW(pB0,10),PKW(pB0,12),PKW(pB0,14)};pw2=(u32x4){PKW(pB1,0),PKW(pB1,2),PKW(pB1,4),PKW(pB1,6)};pw3=(u32x4){PKW(pB1,8),PKW(pB1,10),PKW(pB1,12),PKW(pB1,14)};
    SBAR(); pv(o,vb0+sl_cur,PAF(0),PAF(1),PAF(2),PAF(3)); }
  #undef PKW
  #undef PAF
  #undef VFR
  #undef PIN
  #undef MX3
  #undef GAPA
  #undef GAPB
  #undef EX
  #undef VRD
  #undef KRD
  #undef STEP
  #undef ENDW
  {auto rr=__builtin_amdgcn_permlane32_swap(__float_as_uint(l_reg),__float_as_uint(l_reg),false,false);l_reg=__uint_as_float(rr[0])+__uint_as_float(rr[1]);}
  if(hi==0)wsf[32+r32]=l_reg;asm volatile("s_waitcnt lgkmcnt(0)":::"memory");
  float rli[16];
  #pragma unroll
  for(int r=0;r<16;++r)rli[r]=__builtin_amdgcn_rcpf(wsf[32+crow(r,hi)]);
  bf16*Ow=O+(rowbase+q0+wid*QBLK)*DMA+h*D;
  { bf16*stg=(bf16*)(shm+LDS_OST)+wid*2048;
    #pragma unroll
    for(int r=0;r<16;++r){const int orow=crow(r,hi);
      #pragma unroll
      for(int d0=0;d0<2;++d0)stg[orow*64+d0*32+r32]=__float2bfloat16(o[d0][r]*rli[r]);}
    asm volatile("s_waitcnt lgkmcnt(0)":::"memory");
    #pragma unroll
    for(int i=0;i<4;++i){const int row=i*8+(lane>>3),ch=lane&7; const u32x4 v=*(const u32x4*)(stg+row*64+ch*8); ATTN_STORE16(Ow+(long)row*DMA+ch*8,v);} }
  asm volatile("s_waitcnt lgkmcnt(0)\n\ts_barrier":::"memory");
  #undef DMA_K
  #undef DMA_V
  #undef CMASK
  #undef START
  #undef RESC
  #undef ROT
}
#undef SBAR
#undef WAIT_BAR
}

constexpr size_t MiB = 1u << 20;
constexpr size_t WS_CTL = 0, CTL_ZERO_BYTES = 1 * MiB;
constexpr size_t WS_PART = 1 * MiB;
constexpr size_t WS_SKIN = 3 * MiB;
constexpr size_t WS_WSK  = 5 * MiB;
constexpr size_t WS_WIN = 8 * MiB, WS_WOUT = 20 * MiB, WS_WGU = 24 * MiB, WS_WDOWN = 68 * MiB, WS_WKVQ = 90 * MiB, WS_WQ3 = 96 * MiB, WS_WO = 98 * MiB;
constexpr size_t WS_HB = 104 * MiB;
constexpr size_t WS_BIG = 168 * MiB;
constexpr size_t WS_PROJ = WS_BIG;
constexpr size_t WS_OA = WS_BIG + 192 * MiB;
constexpr size_t WS_ACT_GLA = WS_BIG;
constexpr size_t WS_QO = WS_BIG;
constexpr size_t WS_ACT_FOX = WS_BIG;
constexpr size_t WS_HPART = 424 * MiB;
constexpr size_t WS_HL = 448 * MiB;
constexpr size_t WS_END = 512 * MiB;
static_assert(WS_OA + 64 * MiB <= WS_HL && WS_ACT_FOX + 176 * MiB <= WS_HL && WS_HL + 64 * MiB <= WS_END, "workspace map");
constexpr int CW_BAR = 4096;

constexpr int NWAVES = 8;
constexpr int RING_OFF = 0, RING_BYTES = 131072;
constexpr int LDSCTL_OFF = RING_BYTES, MISC_OFF = LDSCTL_OFF + 320;
constexpr int SEGTBL_OFF = RING_BYTES + 1024;
constexpr int LDS_BYTES = 147456;
static_assert(MISC_OFF + 128 <= SEGTBL_OFF && SEGTBL_OFF + 8192 <= LDS_BYTES, "LDS map");

#define GAS __attribute__((address_space(1)))
#define LAS __attribute__((address_space(3)))
typedef unsigned short bf16;
typedef unsigned v4u __attribute__((ext_vector_type(4)));
typedef unsigned v2u __attribute__((ext_vector_type(2)));
typedef float f32x4 __attribute__((ext_vector_type(4)));
typedef float f32x2 __attribute__((ext_vector_type(2)));
typedef short bf16x8 __attribute__((ext_vector_type(8)));
typedef GAS unsigned gu32;
#define RLX_AGENT __ATOMIC_RELAXED, __HIP_MEMORY_SCOPE_AGENT
#define LDS_WAIT() asm volatile("s_waitcnt lgkmcnt(0)" ::: "memory")
#define VM_WAIT() asm volatile("s_waitcnt vmcnt(0)" ::: "memory")
__device__ __forceinline__ unsigned f2bf(float f) { unsigned u = __builtin_bit_cast(unsigned, f); return (u + 0x7fffu + ((u >> 16) & 1u)) >> 16; }
__device__ __forceinline__ unsigned pk2(float lo, float hi) { return f2bf(lo) | (f2bf(hi) << 16); }
__device__ __forceinline__ float bf2f(unsigned short b) { return __builtin_bit_cast(float, (unsigned)b << 16); }
__device__ __forceinline__ float log_sigmoid_f(float x) { return fminf(x, 0.f) - log1pf(expf(-fabsf(x))); }

#define XB_TMO      128
#define XB_XCNT(j)  (256  + 64 * (j))
#define XB_XSUB(j)  (1280 + 64 * (j))
#define XB_XGEN(j)  (2304 + 64 * (j))
#define XB_TOP      3328
#define XB_TOPGEN   3392
#define XCD_BAR_WORDS 3456
#define XB_SPIN_CAP (1u << 18)
__device__ __forceinline__ unsigned xb_ld(unsigned* p)              { return __hip_atomic_load(p, __ATOMIC_RELAXED, __HIP_MEMORY_SCOPE_AGENT); }
__device__ __forceinline__ unsigned xb_add(unsigned* p, unsigned v) { return __hip_atomic_fetch_add(p, v, __ATOMIC_RELAXED, __HIP_MEMORY_SCOPE_AGENT); }
__device__ __forceinline__ unsigned xb_xcc_id() { return (unsigned)__builtin_amdgcn_s_getreg((3 << 11) | 20) & 0xFu; }
#define XB_SPIN(cond, bar) do { unsigned _sp = 0; while (cond) { __builtin_amdgcn_s_sleep(1); \
    if ((++_sp & 255u) == 0u) { if (xb_ld(&(bar)[XB_TMO])) break; if (_sp > XB_SPIN_CAP) { atomicAdd(&(bar)[XB_TMO], 1u); break; } } } } while (0)
struct XcdBarrier { unsigned* bar; unsigned x; volatile LAS unsigned* st; };
__device__ __forceinline__ XcdBarrier xcd_barrier_post(unsigned* bar, volatile LAS unsigned* st) {
    XcdBarrier b; b.bar = bar; b.x = xb_xcc_id(); b.st = st;
    if (threadIdx.x == 0) (void)xb_add(&bar[XB_XCNT(b.x)], 1u);
    return b;
}
__device__ __forceinline__ void xcd_barrier_complete(unsigned* bar, unsigned x, unsigned& nloc, unsigned& nx) {
    const unsigned G = gridDim.x * gridDim.y * gridDim.z;
    unsigned sum, cnt, mine, sp = 0u;
    for (;;) {
        sum = 0u; cnt = 0u; mine = 0u;
#pragma unroll
        for (unsigned j = 0; j < 16; ++j) { const unsigned c = xb_ld(&bar[XB_XCNT(j)]); sum += c; cnt += (c > 0u) ? 1u : 0u; mine = (j == x) ? c : mine; }
        if (sum == G) break;
        __builtin_amdgcn_s_sleep(1);
        if ((++sp & 255u) == 0u) { if (xb_ld(&bar[XB_TMO])) break; if (sp > XB_SPIN_CAP) { atomicAdd(&bar[XB_TMO], 1u); break; } }
    }
    nloc = mine > 0u ? mine : 1u; nx = cnt > 0u ? cnt : 1u;
}
__device__ __forceinline__ void xcd_barrier(const XcdBarrier& b) {
    asm volatile("s_waitcnt vmcnt(0)" ::: "memory");
    __syncthreads();
    if (threadIdx.x == 0) {
        unsigned* bar = b.bar;
        __builtin_amdgcn_s_waitcnt(0);
        const unsigned nloc = b.st[0], nx = b.st[1];
        const unsigned old = xb_add(&bar[XB_XSUB(b.x)], 1u);
        const unsigned gen = old / nloc;
        if (old + 1u == (gen + 1u) * nloc) {
            __builtin_amdgcn_fence(__ATOMIC_RELEASE, "agent");
            asm volatile("s_waitcnt vmcnt(0)" ::: "memory");
            const unsigned og = xb_add(&bar[XB_TOP], 1u);
            const unsigned tg = og / nx;
            if (og + 1u == (tg + 1u) * nx) xb_add(&bar[XB_TOPGEN], 1u);
            else XB_SPIN(xb_ld(&bar[XB_TOPGEN]) == tg, bar);
            __builtin_amdgcn_fence(__ATOMIC_ACQUIRE, "agent");
            xb_add(&bar[XB_XGEN(b.x)], 1u);
            asm volatile("s_waitcnt vmcnt(0)" ::: "memory");
        } else {
            XB_SPIN(xb_ld(&bar[XB_XGEN(b.x)]) == gen, bar);
            __builtin_amdgcn_fence(__ATOMIC_ACQUIRE, "agent");
            asm volatile("s_waitcnt vmcnt(0)" ::: "memory");
        }
    }
    __syncthreads();
}

struct Frame {
    LAS unsigned char* lds;
    volatile LAS unsigned* MISC;
    gu32* ctl;
    int tid, lane, wave;
    int vcu, G;
};
__device__ __forceinline__ float wave_sum(float v) {
#pragma unroll
    for (int o = 1; o < 64; o <<= 1) v += __shfl_xor(v, o);
    return v;
}

__device__ __forceinline__ void p0_transpose_item(const float* W, int ldw, int c0, int ncols, int K, const float* gain, int gain_mask, float scale, int scale_cols, bf16* WT, int mode, LAS float* scr, int item, int lane) {
    const int nblk = ncols / 32, kb = item / nblk, nb = item % nblk, k0 = 64 * kb, n0 = 32 * nb;
    f32x4 wv[8];
#pragma unroll
    for (int i = 0; i < 8; ++i) { const int kk = 8 * i + (lane >> 3); wv[i] = *(const GAS f32x4*)(W + (size_t)(k0 + kk) * ldw + c0 + n0 + 4 * (lane & 7)); }
#pragma unroll
    for (int i = 0; i < 8; ++i) { const int kk = 8 * i + (lane >> 3); const float gk = gain ? gain[(k0 + kk) & gain_mask] : 1.0f; LAS float* d = scr + kk * 33 + 4 * (lane & 7);
        d[0] = wv[i][0] * gk; d[1] = wv[i][1] * gk; d[2] = wv[i][2] * gk; d[3] = wv[i][3] * gk; }
    LDS_WAIT(); asm volatile("" ::: "memory");
    const float sc = (n0 < scale_cols) ? scale : 1.0f;
    const int c = lane & 7;
#pragma unroll
    for (int j = 0; j < 4; ++j) { const int n = (lane >> 3) + 8 * j; const LAS float* s = scr + (8 * c) * 33 + n;
        v4u o; o.x = pk2(s[0 * 33] * sc, s[1 * 33] * sc); o.y = pk2(s[2 * 33] * sc, s[3 * 33] * sc); o.z = pk2(s[4 * 33] * sc, s[5 * 33] * sc); o.w = pk2(s[6 * 33] * sc, s[7 * 33] * sc);
        const int nn = n0 + n; int row = nn;
        if (mode == 1) { row = (nn < DFF) ? (256 * (nn / 128) + (nn % 128)) : (256 * ((nn - DFF) / 128) + 128 + ((nn - DFF) % 128)); }
        *(GAS v4u*)(WT + (size_t)row * K + k0 + 8 * c) = o; }
    LDS_WAIT(); asm volatile("" ::: "memory");
}

struct Args { const float* in[16]; float* out; unsigned char* ws; int lo, hi; };

__device__ __forceinline__ void skinny_phase(const Frame& F, const bf16* hb, const bf16* Wt, const float* part, float* out) {
    int tid_ = threadIdx.x; asm volatile("" : "+v"(tid_)); const int lane_ = tid_ & 63, wave_ = __builtin_amdgcn_readfirstlane(tid_ >> 6);
    const int gw = F.vcu * NWAVES + wave_, NGW = F.G * NWAVES, fr = lane_ & 15, fq = lane_ >> 4;
    for (int tile = gw; tile < MTOK / 16; tile += NGW) {
        const int row0 = tile * 16;
        const bf16* ap = hb + (size_t)(row0 + fr) * DM + fq * 8; const bf16* bp = Wt + (size_t)fr * DM + fq * 8;
        f32x4 acc = (f32x4){0.f, 0.f, 0.f, 0.f};
#pragma unroll 8
        for (int ks = 0; ks < DM / 32; ++ks) { const bf16x8 a = *(const bf16x8*)(ap + 32 * ks), b = *(const bf16x8*)(bp + 32 * ks); acc = __builtin_amdgcn_mfma_f32_16x16x32_bf16(a, b, acc, 0, 0, 0); }
#pragma unroll
        for (int r = 0; r < 4; ++r) { const int row = row0 + 4 * fq + r; out[(size_t)row * 16 + fr] = acc[r] * pg8::rstd_row(part, row); }
    }
}

__device__ __forceinline__ void alpha_phase(const Frame& F, const bf16* hb, const bf16* Wt, const float* part, const float* Wup, const float* balpha, bf16* la) {
    int tid_ = threadIdx.x; asm volatile("" : "+v"(tid_)); const int lane_ = tid_ & 63, wave_ = __builtin_amdgcn_readfirstlane(tid_ >> 6);
    const int gw = F.vcu * NWAVES + wave_, NGW = F.G * NWAVES, fr = lane_ & 15, fq = lane_ >> 4;
    LAS float* scr = (LAS float*)(F.lds + RING_OFF + wave_ * 2048);
    float w[16][8]; float bb[8];
#pragma unroll
    for (int j = 0; j < 16; ++j) { const f32x4 w0 = *(const GAS f32x4*)(Wup + j * GQK + 8 * lane_), w1 = *(const GAS f32x4*)(Wup + j * GQK + 8 * lane_ + 4);
#pragma unroll
        for (int c = 0; c < 4; ++c) { w[j][c] = w0[c]; w[j][4 + c] = w1[c]; } }
    { const f32x4 b0 = *(const GAS f32x4*)(balpha + 8 * lane_), b1 = *(const GAS f32x4*)(balpha + 8 * lane_ + 4);
#pragma unroll
      for (int c = 0; c < 4; ++c) { bb[c] = b0[c]; bb[4 + c] = b1[c]; } }
    for (int tile = gw; tile < MTOK / 16; tile += NGW) {
        const int row0 = tile * 16;
        const bf16* ap = hb + (size_t)(row0 + fr) * DM + fq * 8; const bf16* bp = Wt + (size_t)fr * DM + fq * 8;
        f32x4 acc = (f32x4){0.f, 0.f, 0.f, 0.f};
#pragma unroll 8
        for (int ks = 0; ks < DM / 32; ++ks) { const bf16x8 a = *(const bf16x8*)(ap + 32 * ks), b = *(const bf16x8*)(bp + 32 * ks); acc = __builtin_amdgcn_mfma_f32_16x16x32_bf16(a, b, acc, 0, 0, 0); }
#pragma unroll
        for (int r = 0; r < 4; ++r) { const int row = row0 + 4 * fq + r; scr[(4 * fq + r) * 16 + fr] = acc[r] * pg8::rstd_row(part, row); }
        LDS_WAIT(); asm volatile("" ::: "memory");
#pragma unroll 2
        for (int r = 0; r < 16; ++r) {
            const LAS f32x4* arow = (const LAS f32x4*)(scr + r * 16);
            float z[8];
#pragma unroll
            for (int c = 0; c < 8; ++c) z[c] = bb[c];
#pragma unroll
            for (int j4 = 0; j4 < 4; ++j4) { const f32x4 a = arow[j4];
#pragma unroll
                for (int e = 0; e < 4; ++e)
#pragma unroll
                    for (int c = 0; c < 8; ++c) z[c] += a[e] * w[4 * j4 + e][c]; }
            float l[8];
#pragma unroll
            for (int c = 0; c < 8; ++c) l[c] = (fminf(z[c], 0.f) - 0.6931471805599453f * __builtin_amdgcn_logf(1.0f + __builtin_amdgcn_exp2f(-fabsf(z[c]) * LOG2E))) * 0.0625f;
            v4u o; o.x = pg8::cvt_pk_bf16(l[0], l[1]); o.y = pg8::cvt_pk_bf16(l[2], l[3]); o.z = pg8::cvt_pk_bf16(l[4], l[5]); o.w = pg8::cvt_pk_bf16(l[6], l[7]);
            *(GAS v4u*)(la + (size_t)(row0 + r) * GQK + 8 * lane_) = o;
        }
        LDS_WAIT(); asm volatile("" ::: "memory");
    }
    __syncthreads();
}

__device__ __forceinline__ void gate_phase(const Frame& F, const bf16* oa, bf16* oa_out, const bf16* proj, const float* ghead) {
    int tid_ = threadIdx.x; asm volatile("" : "+v"(tid_)); const int lane_ = tid_ & 63, wave_ = __builtin_amdgcn_readfirstlane(tid_ >> 6);
    const int gw = F.vcu * NWAVES + wave_, NGW = F.G * NWAVES;
    for (int m = gw; m < MTOK; m += NGW) {
#pragma unroll
        for (int j = 0; j < 2; ++j) {
            const int col = lane_ * 8 + 512 * j;
            const v4u ov = *(const GAS v4u*)(oa + (size_t)m * GV + col); const v4u rv = *(const GAS v4u*)(proj + (size_t)m * GPROJ + 2048 + col);
            float o[8], r[8];
#pragma unroll
            for (int i = 0; i < 4; ++i) { o[2 * i] = __builtin_bit_cast(float, ov[i] << 16); o[2 * i + 1] = __builtin_bit_cast(float, ov[i] & 0xffff0000u); r[2 * i] = __builtin_bit_cast(float, rv[i] << 16); r[2 * i + 1] = __builtin_bit_cast(float, rv[i] & 0xffff0000u); }
            float ss = 0.f;
#pragma unroll
            for (int i = 0; i < 8; ++i) ss += o[i] * o[i];
#pragma unroll
            for (int s = 1; s < 32; s <<= 1) ss += __shfl_xor(ss, s);
            const float rs = 1.0f / sqrtf(ss * (1.0f / 256.0f) + EPS);
            const f32x4 g0 = *(const GAS f32x4*)(ghead + (col & 255)), g1 = *(const GAS f32x4*)(ghead + (col & 255) + 4);
            float a[8];
#pragma unroll
            for (int i = 0; i < 8; ++i) { const float g = i < 4 ? g0[i] : g1[i - 4]; a[i] = o[i] * rs * g * pg8::silu_f(r[i]); }
            v4u w; w.x = pk2(a[0], a[1]); w.y = pk2(a[2], a[3]); w.z = pk2(a[4], a[5]); w.w = pk2(a[6], a[7]);
            *(GAS v4u*)(oa_out + (size_t)m * GV + col) = w;
        }
    }
}

__device__ __forceinline__ void final_phase(const Frame& F, float* out, const bf16* hi, const bf16* lo, const float* part, const float* g) {
    int tid_ = threadIdx.x; asm volatile("" : "+v"(tid_)); const int lane_ = tid_ & 63, wave_ = __builtin_amdgcn_readfirstlane(tid_ >> 6);
    const int gw = F.vcu * NWAVES + wave_, NGW = F.G * NWAVES;
    for (int m = gw; m < MTOK; m += NGW) {
        const float rs = pg8::rstd_row(part, m);
#pragma unroll
        for (int j = 0; j < 2; ++j) {
            const int col = lane_ * 8 + 512 * j;
            const v4u a = *(const GAS v4u*)(hi + (size_t)m * DM + col), b = *(const GAS v4u*)(lo + (size_t)m * DM + col);
            const f32x4 g0 = *(const GAS f32x4*)(g + col), g1 = *(const GAS f32x4*)(g + col + 4);
            f32x4 o0, o1;
#pragma unroll
            for (int i = 0; i < 2; ++i) {
                o0[2 * i] = (__builtin_bit_cast(float, a[i] << 16) + __builtin_bit_cast(float, b[i] << 16)) * rs * g0[2 * i];
                o0[2 * i + 1] = (__builtin_bit_cast(float, a[i] & 0xffff0000u) + __builtin_bit_cast(float, b[i] & 0xffff0000u)) * rs * g0[2 * i + 1];
                o1[2 * i] = (__builtin_bit_cast(float, a[2 + i] << 16) + __builtin_bit_cast(float, b[2 + i] << 16)) * rs * g1[2 * i];
                o1[2 * i + 1] = (__builtin_bit_cast(float, a[2 + i] & 0xffff0000u) + __builtin_bit_cast(float, b[2 + i] & 0xffff0000u)) * rs * g1[2 * i + 1]; }
            *(GAS f32x4*)(out + (size_t)m * DM + col) = o0; *(GAS f32x4*)(out + (size_t)m * DM + col + 4) = o1;
        }
    }
}

namespace gla {
constexpr int QD_OFF = 0, KD_OFF = 17408, KE_OFF = 34816, VT_OFF = 53248, AM_OFF = 62464, ST_OFF = 71680, AL_OFF = 89088, SEG_OFF = 93184, DEC_OFF = 97280, LDS_END = 97792;
constexpr int SW = 272, SN = 144;
static_assert(LDS_END <= RING_BYTES, "scan LDS map");
}
__device__ __forceinline__ void scan_phase(const Frame& F, const bf16* proj, const bf16* la, bf16* oa, float* hpart) {
    using namespace gla;
#define SCAN_SYNC() do { asm volatile("s_waitcnt lgkmcnt(0)" ::: "memory"); __builtin_amdgcn_s_barrier(); asm volatile("" ::: "memory"); } while (0)
    typedef LAS const bf16x8* lfrag;
    int tid_ = threadIdx.x; asm volatile("" : "+v"(tid_));
    const int tid = tid_, lane = tid & 63, wave = __builtin_amdgcn_readfirstlane(tid >> 6), fr = lane & 15, fq = lane >> 4;
    LAS unsigned char* L = F.lds + RING_OFF;
    for (int unit = F.vcu; unit < BATCH * GH * 4; unit += F.G) {
        const int bh = unit >> 2, sl = unit & 3, b = bh >> 2, h = bh & 3;
        const size_t row0 = (size_t)b * SEQ;
        const int d0 = 2 * lane;
        f32x4 S[4];
#pragma unroll
        for (int i = 0; i < 4; ++i) S[i] = (f32x4){0.f, 0.f, 0.f, 0.f};
        for (int i = tid; i < (64 * SW) / 4; i += NWAVES * 64) ((LAS unsigned*)(L + ST_OFF))[i] = 0u;
        const bf16* qbase = proj + (row0 + 8 * wave) * GPROJ + h * GDK + d0;
        const bf16* vbase = proj + (row0 + 8 * wave) * GPROJ + 2 * GQK + h * GDV + 64 * sl + lane;
        const bf16* lbase = la + (row0 + 8 * wave) * GQK + h * GDK + d0;
        const bf16* rbase = proj + (row0 + 16 * (wave >> 1) + 4 * fq) * GPROJ + 2 * GQK + GV + h * GDV + 64 * sl + 32 * (wave & 1) + fr;
        unsigned qreg[8], kreg[8], vreg[8], lreg[8], rreg[8];
#define GLA_LOAD(n) do { _Pragma("unroll") for (int i = 0; i < 8; ++i) { const size_t ro = ((size_t)(n) * 64 + i) * GPROJ; qreg[i] = *(const unsigned*)(qbase + ro); kreg[i] = *(const unsigned*)(qbase + ro + GQK); vreg[i] = (unsigned)vbase[ro]; \
            lreg[i] = *(const unsigned*)(lbase + ((size_t)(n) * 64 + i) * GQK); } \
        _Pragma("unroll") for (int j = 0; j < 4; ++j) { const size_t ro = ((size_t)(n) * 64 + j) * GPROJ; rreg[j] = (unsigned)rbase[ro]; rreg[4 + j] = (unsigned)rbase[ro + 16]; } } while (0)
        GLA_LOAD(0);
        SCAN_SYNC();
        for (int n = 0; n < SEQ / 64; ++n) {
#pragma unroll
            for (int i = 0; i < 8; ++i) asm volatile("" : "+v"(lreg[i]));
            float loc0[8], loc1[8]; float run0 = 0.f, run1 = 0.f;
#pragma unroll
            for (int i = 0; i < 8; ++i) { run0 += __builtin_bit_cast(float, lreg[i] << 16); run1 += __builtin_bit_cast(float, lreg[i] & 0xffff0000u); loc0[i] = run0; loc1[i] = run1; }
            *(LAS f32x2*)(L + SEG_OFF + (wave * 128 + d0) * 4) = (f32x2){run0, run1};
            SCAN_SYNC();
#pragma unroll
            for (int i = 0; i < 8; ++i) asm volatile("" : "+v"(qreg[i]), "+v"(kreg[i]), "+v"(vreg[i]));
            float off0 = 0.f, off1 = 0.f, tot0 = 0.f, tot1 = 0.f;
#pragma unroll
            for (int w = 0; w < 8; ++w) { const f32x2 t2 = *(const LAS f32x2*)(L + SEG_OFF + (w * 128 + d0) * 4); if (w < wave) { off0 += t2.x; off1 += t2.y; } tot0 += t2.x; tot1 += t2.y; }
            const float edl0 = __builtin_amdgcn_exp2f(tot0 * LOG2E), edl1 = __builtin_amdgcn_exp2f(tot1 * LOG2E);
            unsigned ke0[4], ke1[4];
#pragma unroll
            for (int i = 0; i < 8; i += 2) {
                float kev0[2], kev1[2];
#pragma unroll
                for (int u = 0; u < 2; ++u) {
                    const float b0 = (off0 + loc0[i + u]) * LOG2E, b1 = (off1 + loc1[i + u]) * LOG2E;
                    const float eb0 = __builtin_amdgcn_exp2f(b0), eb1 = __builtin_amdgcn_exp2f(b1), en0 = __builtin_amdgcn_exp2f(-b0), en1 = __builtin_amdgcn_exp2f(-b1);
                    const float q0 = __builtin_bit_cast(float, qreg[i + u] << 16), q1 = __builtin_bit_cast(float, qreg[i + u] & 0xffff0000u);
                    const float k0 = __builtin_bit_cast(float, kreg[i + u] << 16), k1 = __builtin_bit_cast(float, kreg[i + u] & 0xffff0000u);
                    const int c = 8 * wave + i + u;
                    *(LAS unsigned*)(L + QD_OFF + c * SW + 2 * d0) = pg8::cvt_pk_bf16(q0 * eb0, q1 * eb1);
                    *(LAS unsigned*)(L + KD_OFF + c * SW + 2 * d0) = pg8::cvt_pk_bf16(k0 * en0, k1 * en1);
                    kev0[u] = k0 * en0 * edl0; kev1[u] = k1 * en1 * edl1;
                }
                ke0[i >> 1] = pg8::cvt_pk_bf16(kev0[0], kev0[1]); ke1[i >> 1] = pg8::cvt_pk_bf16(kev1[0], kev1[1]);
            }
            *(LAS v4u*)(L + KE_OFF + d0 * SN + 16 * wave) = (v4u){ke0[0], ke0[1], ke0[2], ke0[3]};
            *(LAS v4u*)(L + KE_OFF + (d0 + 1) * SN + 16 * wave) = (v4u){ke1[0], ke1[1], ke1[2], ke1[3]};
            if (wave == 0) *(LAS f32x2*)(L + DEC_OFF + d0 * 4) = (f32x2){edl0, edl1};
            { v4u vv; vv.x = vreg[0] | (vreg[1] << 16); vv.y = vreg[2] | (vreg[3] << 16); vv.z = vreg[4] | (vreg[5] << 16); vv.w = vreg[6] | (vreg[7] << 16);
              *(LAS v4u*)(L + VT_OFF + lane * SN + 16 * wave) = vv; }
            unsigned rcur[8];
#pragma unroll
            for (int j = 0; j < 8; ++j) { asm volatile("" : "+v"(rreg[j])); rcur[j] = rreg[j]; }
            if (n + 1 < SEQ / 64) GLA_LOAD(n + 1);
            SCAN_SYNC();
            {
                const int ci = wave >> 1, sh = wave & 1;
#pragma unroll
                for (int tt = 0; tt < 2; ++tt) {
                    const int si = 2 * sh + tt; f32x4 acc = (f32x4){0.f, 0.f, 0.f, 0.f};
                    if (si <= ci) {
#pragma unroll
                        for (int ks = 0; ks < 4; ++ks) { const bf16x8 a = *(lfrag)(L + QD_OFF + (16 * ci + fr) * SW + (32 * ks + 8 * fq) * 2), bb = *(lfrag)(L + KD_OFF + (16 * si + fr) * SW + (32 * ks + 8 * fq) * 2);
                            acc = __builtin_amdgcn_mfma_f32_16x16x32_bf16(a, bb, acc, 0, 0, 0); }
                    }
#pragma unroll
                    for (int r = 0; r < 4; ++r) { const int c = 16 * ci + 4 * fq + r, sx = 16 * si + fr; const float v = (sx <= c) ? acc[r] : 0.f;
                        *(LAS unsigned short*)(L + AM_OFF + c * SN + 2 * sx) = (unsigned short)f2bf(v); }
                }
            }
            {
                const f32x4 dec = *(const LAS f32x4*)(L + DEC_OFF + (16 * wave + 4 * fq) * 4);
#pragma unroll
                for (int vi = 0; vi < 4; ++vi) S[vi] = S[vi] * dec;
#pragma unroll
                for (int ks = 0; ks < 2; ++ks) { const bf16x8 a = *(lfrag)(L + KE_OFF + (16 * wave + fr) * SN + (32 * ks + 8 * fq) * 2);
#pragma unroll
                    for (int vi = 0; vi < 4; ++vi) { const bf16x8 bb = *(lfrag)(L + VT_OFF + (16 * vi + fr) * SN + (32 * ks + 8 * fq) * 2); S[vi] = __builtin_amdgcn_mfma_f32_16x16x32_bf16(a, bb, S[vi], 0, 0, 0); } }
            }
            SCAN_SYNC();
            {
                const int ci = wave >> 1, vh = wave & 1; f32x4 o0 = (f32x4){0.f, 0.f, 0.f, 0.f}, o1 = o0;
#pragma unroll
                for (int ks = 0; ks < 2; ++ks) { if (ks == 1 && ci < 2) continue;
                    const bf16x8 a = *(lfrag)(L + AM_OFF + (16 * ci + fr) * SN + (32 * ks + 8 * fq) * 2);
                    const bf16x8 b0 = *(lfrag)(L + VT_OFF + (32 * vh + fr) * SN + (32 * ks + 8 * fq) * 2), b1 = *(lfrag)(L + VT_OFF + (32 * vh + 16 + fr) * SN + (32 * ks + 8 * fq) * 2);
                    o0 = __builtin_amdgcn_mfma_f32_16x16x32_bf16(a, b0, o0, 0, 0, 0); o1 = __builtin_amdgcn_mfma_f32_16x16x32_bf16(a, b1, o1, 0, 0, 0); }
#pragma unroll
                for (int ks = 0; ks < 4; ++ks) {
                    const bf16x8 a = *(lfrag)(L + QD_OFF + (16 * ci + fr) * SW + (32 * ks + 8 * fq) * 2);
                    const bf16x8 b0 = *(lfrag)(L + ST_OFF + (32 * vh + fr) * SW + (32 * ks + 8 * fq) * 2), b1 = *(lfrag)(L + ST_OFF + (32 * vh + 16 + fr) * SW + (32 * ks + 8 * fq) * 2);
                    o0 = __builtin_amdgcn_mfma_f32_16x16x32_bf16(a, b0, o0, 0, 0, 0); o1 = __builtin_amdgcn_mfma_f32_16x16x32_bf16(a, b1, o1, 0, 0, 0); }
                const size_t orow = row0 + (size_t)n * 64 + 16 * ci + 4 * fq;
                bf16* op = oa + orow * GV + h * GDV + 64 * sl + 32 * vh + fr;
#pragma unroll
                for (int r = 0; r < 4; ++r) {
                    float ss = o0[r] * o0[r] + o1[r] * o1[r];
                    ss += __shfl_xor(ss, 1); ss += __shfl_xor(ss, 2); ss += __shfl_xor(ss, 4); ss += __shfl_xor(ss, 8);
                    if (fr == 0) hpart[(orow + r) * 32 + 8 * h + 2 * sl + vh] = ss;
                    const float r0 = __builtin_bit_cast(float, rcur[r] << 16), r1 = __builtin_bit_cast(float, rcur[4 + r] << 16);
                    op[(size_t)r * GV] = (bf16)f2bf(o0[r] * pg8::silu_f(r0)); op[(size_t)r * GV + 16] = (bf16)f2bf(o1[r] * pg8::silu_f(r1));
                }
            }
            SCAN_SYNC();
#pragma unroll
            for (int vi = 0; vi < 4; ++vi) { v2u w; w.x = pg8::cvt_pk_bf16(S[vi][0], S[vi][1]); w.y = pg8::cvt_pk_bf16(S[vi][2], S[vi][3]);
                *(LAS v2u*)(L + ST_OFF + (16 * vi + fr) * SW + (16 * wave + 4 * fq) * 2) = w; }
        }
#undef GLA_LOAD
        SCAN_SYNC();
    }
#undef SCAN_SYNC
}

__device__ __forceinline__ void attn_phase(const Frame& F, unsigned char* lds_generic, const float* flog, const float* b_f, const bf16* Q, const bf16* K, const bf16* V, bf16* O) {
    for (int bh = F.vcu; bh < BATCH * FH; bh += F.G) {
        const int b = bh / FH, h = bh % FH;
        LAS float* bt = (LAS float*)(F.lds + RING_OFF + attn_body::LDS_BIAS); LAS float* wt = (LAS float*)(F.lds + RING_OFF + attn_body::LDS_SCAN);
        const float bf = b_f[h];
        float ls[4]; float run = 0.f;
#pragma unroll
        for (int i = 0; i < 4; ++i) { const float x = flog[((size_t)b * SEQ + 4 * F.tid + i) * 16 + h] + bf; run += log_sigmoid_f(x); ls[i] = run; }
        float incl = run;
#pragma unroll
        for (int o = 1; o < 64; o <<= 1) { const float y = __shfl_up(incl, o); if (F.lane >= o) incl += y; }
        if (F.lane == 63) wt[F.wave] = incl;
        LDS_WAIT(); __syncthreads();
        float off = 0.f;
        for (int w = 0; w < F.wave; ++w) off += wt[w];
        const float excl = off + incl - run;
#pragma unroll
        for (int i = 0; i < 4; ++i) bt[4 * F.tid + i] = -(excl + ls[i]) * LOG2E;
        LDS_WAIT(); __syncthreads();
        LAS int* t0tab = (LAS int*)(wt + 8);
        {
            constexpr float TSKIP = 28.0f;
            typedef __bf16 bf2_t __attribute__((ext_vector_type(2)));
            const size_t rowb = (size_t)b * SEQ + 4 * F.tid;
            float kkmax = 0.f;
#pragma unroll 1
            for (int i = 0; i < 4; ++i) {
                const GAS v4u* kp = (const GAS v4u*)(K + (rowb + i) * DM + h * FHD); float kk = 0.f;
#pragma unroll
                for (int c = 0; c < 8; ++c) { const v4u k4 = kp[c];
#pragma unroll
                    for (int e = 0; e < 4; ++e) { const bf2_t kv = __builtin_bit_cast(bf2_t, k4[e]); kk = __builtin_amdgcn_fdot2_f32_bf16(kv, kv, kk, false); } }
                kkmax = fmaxf(kkmax, kk);
            }
#pragma unroll
            for (int o = 1; o < 64; o <<= 1) kkmax = fmaxf(kkmax, __shfl_xor(kkmax, o));
            if (F.lane == 0) wt[F.wave] = kkmax;
            LDS_WAIT(); __syncthreads();
            float km = 0.f;
            for (int w = 0; w < 8; ++w) km = fmaxf(km, wt[w]);
            const float Kmax = sqrtf(km) * 1.001f;
            float thr = INFINITY;
#pragma unroll 1
            for (int i = 0; i < 4; ++i) {
                const GAS v4u* qp = (const GAS v4u*)(Q + (rowb + i) * DM + h * FHD); const GAS v4u* kp = (const GAS v4u*)(K + (rowb + i) * DM + h * FHD);
                float qq = 0.f, dk = 0.f;
#pragma unroll
                for (int c = 0; c < 8; ++c) { const v4u a = qp[c], k4 = kp[c];
#pragma unroll
                    for (int e = 0; e < 4; ++e) { const bf2_t qv = __builtin_bit_cast(bf2_t, a[e]), kv = __builtin_bit_cast(bf2_t, k4[e]);
                        qq = __builtin_amdgcn_fdot2_f32_bf16(qv, qv, qq, false); dk = __builtin_amdgcn_fdot2_f32_bf16(qv, kv, dk, false); } }
                thr = fminf(thr, bt[4 * F.tid + i] + dk - TSKIP - sqrtf(qq) * 1.001f * Kmax - 0.01f);
            }
#pragma unroll
            for (int o = 1; o < 64; o <<= 1) thr = fminf(thr, __shfl_xor(thr, o));
            const bool skippable = (F.lane < 32) && (bt[64 * (F.lane & 31) + 63] < thr);
            const unsigned long long bal = __ballot(skippable);
            int lead = __ffsll((long long)~bal) - 1;
            lead = lead < 4 * F.wave ? lead : 4 * F.wave;
            if (F.lane == 0) t0tab[F.wave] = lead & ~1;
            LDS_WAIT(); __syncthreads();
        }
        for (int i = 0; i < attn_body::NQB; ++i) { const int qb = attn_body::NQB - 1 - i; const int t0 = __builtin_amdgcn_readfirstlane(t0tab[qb]);
            attn_body::attn_unit<8>(b, h, qb, t0, (const attn_body::bf16*)Q, (const attn_body::bf16*)K, (const attn_body::bf16*)V, (attn_body::bf16*)O, (char*)lds_generic + RING_OFF); }
        __syncthreads();
    }
}

__global__ void __launch_bounds__(NWAVES * 64, 2) yoco_fwd(Args args) {
    extern __shared__ __attribute__((aligned(16))) unsigned char lds[];
    Frame F;
    F.lds = (LAS unsigned char*)lds;
    F.MISC = (volatile LAS unsigned*)(F.lds + MISC_OFF);
    F.tid = threadIdx.x; F.lane = F.tid & 63; F.wave = __builtin_amdgcn_readfirstlane(F.tid >> 6);
    F.G = gridDim.x; { const int bx = blockIdx.x; F.vcu = (F.G % 8 == 0) ? (bx % 8) * (F.G / 8) + bx / 8 : bx; }
    unsigned char* ws = args.ws;
    F.ctl = (gu32*)(ws + WS_CTL);
    const int lo = args.lo, hi = args.hi;
    for (int u = F.tid; u < (LDS_BYTES - LDSCTL_OFF) / 4; u += NWAVES * 64) ((LAS unsigned*)(F.lds + LDSCTL_OFF))[u] = 0u;
    __syncthreads();
    XcdBarrier bar; bar.bar = (unsigned*)(F.ctl + CW_BAR); bar.x = 0; bar.st = nullptr;
    if (hi - lo > 1) {
        bar = xcd_barrier_post((unsigned*)(F.ctl + CW_BAR), F.MISC + 8);
        if (F.tid == 0) { unsigned nloc, nx; xcd_barrier_complete(bar.bar, bar.x, nloc, nx); bar.st[0] = nloc; bar.st[1] = nx; }
        __syncthreads();
    }
#define ON(s) (lo <= (s) && (s) < hi)
#define SEAM(s) do { if (lo <= (s) && (s) + 1 < hi) xcd_barrier(bar); } while (0)

    const float* x = args.in[0]; const float* attn_norm = args.in[1]; const float* ffn_norm = args.in[2]; const float* gla_w_in = args.in[3];
    const float* gla_g_head = args.in[6]; const float* gla_w_out = args.in[7];
    const float* kv_norm = args.in[8]; const float* w_kv = args.in[9]; const float* b_f = args.in[10]; const float* fox_w_q = args.in[11]; const float* fox_w_o = args.in[12];
    const float* ffn_w_gu = args.in[13]; const float* ffn_w_down = args.in[14]; const float* final_norm = args.in[15];
    float* out = args.out;
    float* part = (float*)(ws + WS_PART); float* skin = (float*)(ws + WS_SKIN); bf16* wsk = (bf16*)(ws + WS_WSK);
    bf16* Win_t = (bf16*)(ws + WS_WIN); bf16* Wout_t = (bf16*)(ws + WS_WOUT); bf16* Wgu_t = (bf16*)(ws + WS_WGU); bf16* Wdown_t = (bf16*)(ws + WS_WDOWN);
    bf16* Wkvq_t = (bf16*)(ws + WS_WKVQ); bf16* Wq3_t = (bf16*)(ws + WS_WQ3); bf16* Wo_t = (bf16*)(ws + WS_WO);
    bf16* hb = (bf16*)(ws + WS_HB); bf16* proj = (bf16*)(ws + WS_PROJ); bf16* oa = (bf16*)(ws + WS_OA);
    bf16* Kb = (bf16*)out; bf16* Vb = (bf16*)out + (size_t)MTOK * DM; bf16* QO = (bf16*)(ws + WS_QO); bf16* hl = (bf16*)(ws + WS_HL); bf16* lab = (bf16*)out; float* hpart = (float*)(ws + WS_HPART);

    if (ON(0)) {
        LAS float* scr = (LAS float*)(F.lds + RING_OFF + F.wave * 16384);
        const int gw = F.vcu * NWAVES + F.wave, NGW = F.G * NWAVES;
        constexpr int I_IN = (DM / 64) * (GPROJ / 32), I_SQ = (DM / 64) * (DM / 32), I_GU = (DM / 64) * (NGU / 32), I_DN = (DFF / 64) * (DM / 32), I_KV = (DM / 64) * (2048 / 32);
        constexpr int NITEMS = 2 * I_IN + 2 * I_SQ + 4 * I_GU + 4 * I_DN + I_KV + 2 * I_SQ + 2 * I_SQ;
        for (int it = gw; it < NITEMS; it += NGW) {
            int r = it;
            if (r < 2 * I_IN) { const int l = r / I_IN; r -= l * I_IN; p0_transpose_item(gla_w_in + (size_t)l * DM * GIN, GIN, 0, GPROJ, DM, attn_norm + l * DM, 0x7fffffff, QSCALE_GLA, GQK, Win_t + (size_t)l * GPROJ * DM, 0, scr, r, F.lane); continue; } r -= 2 * I_IN;
            if (r < 2 * I_SQ) { const int l = r / I_SQ; r -= l * I_SQ; p0_transpose_item(gla_w_out + (size_t)l * DM * DM, DM, 0, DM, DM, gla_g_head + l * GDV, 255, 1.f, 0, Wout_t + (size_t)l * DM * DM, 0, scr, r, F.lane); continue; } r -= 2 * I_SQ;
            if (r < 4 * I_GU) { const int l = r / I_GU; r -= l * I_GU; p0_transpose_item(ffn_w_gu + (size_t)l * DM * NGU, NGU, 0, NGU, DM, ffn_norm + l * DM, 0x7fffffff, 1.f, 0, Wgu_t + (size_t)l * NGU * DM, 1, scr, r, F.lane); continue; } r -= 4 * I_GU;
            if (r < 4 * I_DN) { const int l = r / I_DN; r -= l * I_DN; p0_transpose_item(ffn_w_down + (size_t)l * DFF * DM, DM, 0, DM, DFF, nullptr, 0x7fffffff, 1.f, 0, Wdown_t + (size_t)l * DM * DFF, 0, scr, r, F.lane); continue; } r -= 4 * I_DN;
            if (r < I_KV) { p0_transpose_item(w_kv, KVOUT, 0, 2048, DM, kv_norm, 0x7fffffff, 1.f, 0, Wkvq_t, 0, scr, r, F.lane); continue; } r -= I_KV;
            if (r < 2 * I_SQ) { const int l = r / I_SQ; r -= l * I_SQ; p0_transpose_item(fox_w_q + (size_t)l * DM * DM, DM, 0, DM, DM, attn_norm + (2 + l) * DM, 0x7fffffff, QSCALE_FOX, DM, l == 0 ? Wkvq_t + (size_t)2048 * DM : Wq3_t, 0, scr, r, F.lane); continue; } r -= 2 * I_SQ;
            { const int l = r / I_SQ; r -= l * I_SQ; p0_transpose_item(fox_w_o + (size_t)l * DM * DM, DM, 0, DM, DM, nullptr, 0x7fffffff, 1.f, 0, Wo_t + (size_t)l * DM * DM, 0, scr, r, F.lane); }
        }
        for (int e = (F.vcu * NWAVES * 64 + F.tid); e < 3 * 16 * DM; e += F.G * NWAVES * 64) {
            const int j = e / (16 * DM), n = (e / DM) % 16, k = e % DM; float v;
            if (j < 2) v = gla_w_in[(size_t)j * DM * GIN + (size_t)k * GIN + GPROJ + n] * attn_norm[j * DM + k]; else v = w_kv[(size_t)k * KVOUT + 2048 + n] * kv_norm[k];
            wsk[e] = (bf16)f2bf(v);
        }
        for (int m = gw; m < MTOK; m += NGW) {
            const GAS f32x4* xr = (const GAS f32x4*)(x + (size_t)m * DM) + F.lane; f32x4 v[4]; float s = 0.f;
#pragma unroll
            for (int j = 0; j < 4; ++j) { v[j] = xr[64 * j]; s += (v[j][0] * v[j][0] + v[j][1] * v[j][1]) + (v[j][2] * v[j][2] + v[j][3] * v[j][3]); }
            s = wave_sum(s);
            GAS v2u* o8 = (GAS v2u*)(hb + (size_t)m * DM) + F.lane;
#pragma unroll
            for (int j = 0; j < 4; ++j) { v2u w; w.x = pk2(v[j][0], v[j][1]); w.y = pk2(v[j][2], v[j][3]); o8[64 * j] = w; }
            if (F.lane < 16) part[(size_t)m * 16 + F.lane] = (F.lane == 0) ? s : 0.f;
        }
    }
    SEAM(0);

    for (int l = 0; l < 2; ++l) {
        const int sb = 1 + 6 * l;
        const float* hin = (l == 0) ? x : nullptr;
        if (ON(sb)) {
            alpha_phase(F, hb, wsk + (size_t)l * 16 * DM, part, args.in[4] + (size_t)l * GRANK * GQK, args.in[5] + (size_t)l * GQK, lab);
            pg8::Gemm g{hb, Win_t + (size_t)l * GPROJ * DM, MTOK, GPROJ, DM}; pg8::StaticOrder S; S.init(MTOK, GPROJ, F.G, (int)blockIdx.x);
            pg8::EpiRowScaleBf16 E{proj, GPROJ, part, 0, nullptr, nullptr};
            pg8::gemm_phase<pg8::EpiRowScaleBf16, pg8::StaticOrder, true, true>(F.lds + RING_OFF, g, S, E);
        }
        SEAM(sb);
        if (ON(sb + 1)) {
            scan_phase(F, proj, lab, oa, hpart);
        }
        SEAM(sb + 1);
        if (ON(sb + 3)) {
            pg8::Gemm g{oa, Wout_t + (size_t)l * DM * DM, MTOK, DM, DM}; pg8::StaticOrder S; S.init(MTOK, DM, F.G, (int)blockIdx.x);
            pg8::EpiResidSeg E{hin, hb, hl, part, hpart, (LAS float*)(F.lds + SEGTBL_OFF)};
            pg8::gemm_phase<pg8::EpiResidSeg, pg8::StaticOrder, true, true>(F.lds + RING_OFF, g, S, E);
        }
        SEAM(sb + 3);
        bf16* act = (bf16*)(ws + WS_ACT_GLA);
        if (ON(sb + 4)) {
            pg8::Gemm g{hb, Wgu_t + (size_t)l * NGU * DM, MTOK, NGU, DM}; pg8::StaticOrder S; S.init(MTOK, NGU, F.G, (int)blockIdx.x);
            pg8::EpiSwiglu E{act, DFF, part};
            pg8::gemm_phase<pg8::EpiSwiglu, pg8::StaticOrder, true, true>(F.lds + RING_OFF, g, S, E);
        }
        SEAM(sb + 4);
        if (ON(sb + 5)) {
            pg8::Gemm g{act, Wdown_t + (size_t)l * DM * DFF, MTOK, DM, DFF}; pg8::StaticOrder S; S.init(MTOK, DM, F.G, (int)blockIdx.x);
            pg8::EpiResid E{nullptr, hb, hl, part};
            pg8::gemm_phase<pg8::EpiResid, pg8::StaticOrder, true, true>(F.lds + RING_OFF, g, S, E);
        }
        SEAM(sb + 5);
    }

    for (int j = 0; j < 2; ++j) {
        const int sb = 13 + 5 * j;
        if (ON(sb)) {
            if (j == 0) {
                skinny_phase(F, hb, wsk + (size_t)2 * 16 * DM, part, skin);
                pg8::Gemm g{hb, Wkvq_t, MTOK, 3 * DM, DM}; pg8::StaticOrder S; S.init(MTOK, 3 * DM, F.G, (int)blockIdx.x);
                pg8::EpiRowScaleBf16 E{Kb, DM, part, DM, Vb, QO};
                pg8::gemm_phase<pg8::EpiRowScaleBf16, pg8::StaticOrder, true, true>(F.lds + RING_OFF, g, S, E);
            } else {
                pg8::Gemm g{hb, Wq3_t, MTOK, DM, DM}; pg8::StaticOrder S; S.init(MTOK, DM, F.G, (int)blockIdx.x);
                pg8::EpiRowScaleBf16 E{QO, DM, part, 0, nullptr, nullptr};
                pg8::gemm_phase<pg8::EpiRowScaleBf16, pg8::StaticOrder, true, true>(F.lds + RING_OFF, g, S, E);
            }
        }
        SEAM(sb);
        if (ON(sb + 1)) {
            attn_phase(F, lds, skin, b_f, QO, Kb, Vb, QO);
        }
        SEAM(sb + 1);
        if (ON(sb + 2)) {
            pg8::Gemm g{QO, Wo_t + (size_t)j * DM * DM, MTOK, DM, DM}; pg8::StaticOrder S; S.init(MTOK, DM, F.G, (int)blockIdx.x);
            pg8::EpiResid E{nullptr, hb, hl, part};
            pg8::gemm_phase<pg8::EpiResid, pg8::StaticOrder, true, true>(F.lds + RING_OFF, g, S, E);
        }
        SEAM(sb + 2);
        bf16* act = (bf16*)(ws + WS_ACT_FOX);
        if (ON(sb + 3)) {
            pg8::Gemm g{hb, Wgu_t + (size_t)(2 + j) * NGU * DM, MTOK, NGU, DM}; pg8::StaticOrder S; S.init(MTOK, NGU, F.G, (int)blockIdx.x);
            pg8::EpiSwiglu E{act, DFF, part};
            pg8::gemm_phase<pg8::EpiSwiglu, pg8::StaticOrder, true, true>(F.lds + RING_OFF, g, S, E);
        }
        SEAM(sb + 3);
        if (ON(sb + 4)) {
            pg8::Gemm g{act, Wdown_t + (size_t)(2 + j) * DM * DFF, MTOK, DM, DFF}; pg8::StaticOrder S; S.init(MTOK, DM, F.G, (int)blockIdx.x);
            pg8::EpiResid E{nullptr, hb, hl, part};
            pg8::gemm_phase<pg8::EpiResid, pg8::StaticOrder, true, true>(F.lds + RING_OFF, g, S, E);
        }
        SEAM(sb + 4);
    }
    if (ON(23)) final_phase(F, out, hb, hl, part, final_norm);
#undef ON
#undef SEAM
}

extern "C" void kernel_launch(void* const* d_in, const int* in_sizes, int n_in, void* d_out, int out_size, void* d_ws, size_t ws_size, hipStream_t stream) {
    static int grid = 0;
    if (grid == 0) {
        if (n_in != 16 || out_size != MTOK * DM || ws_size < WS_END) { fprintf(stderr, "kernel_launch: unexpected shapes (n_in %d, out %d, ws %zu)\n", n_in, out_size, ws_size); grid = -1; return; }
        int dev = 0, cus = 0, per_cu = 0;
        if (hipGetDevice(&dev) != hipSuccess || hipDeviceGetAttribute(&cus, hipDeviceAttributeMultiprocessorCount, dev) != hipSuccess) { grid = -1; return; }
        if (hipFuncSetAttribute((const void*)yoco_fwd, hipFuncAttributeMaxDynamicSharedMemorySize, LDS_BYTES) != hipSuccess) { fprintf(stderr, "kernel_launch: hipFuncSetAttribute failed\n"); grid = -1; return; }
        if (hipOccupancyMaxActiveBlocksPerMultiprocessor(&per_cu, (const void*)yoco_fwd, NWAVES * 64, LDS_BYTES) != hipSuccess || per_cu < 1) fprintf(stderr, "kernel_launch: occupancy query reports %d\n", per_cu);
        (void)hipGetLastError();
        grid = cus;
    }
    if (grid < 0) return;
    (void)hipMemsetAsync((char*)d_ws + WS_CTL, 0, CTL_ZERO_BYTES, stream);
    Args a{};
    for (int i = 0; i < 16; ++i) a.in[i] = (const float*)d_in[i];
    a.out = (float*)d_out; a.ws = (unsigned char*)d_ws;
#if KMODE == 1
    a.lo = 0; a.hi = 24;
    hipLaunchKernelGGL(yoco_fwd, dim3(grid), dim3(NWAVES * 64), LDS_BYTES, stream, a);
#else
    for (int s = 0; s < 24; ++s) { a.lo = s; a.hi = s + 1; hipLaunchKernelGGL(yoco_fwd, dim3(grid), dim3(NWAVES * 64), LDS_BYTES, stream, a); }
#endif
}
```
